# Optimizing an MI355X kernel written in HIP

```python
import jax
import jax.numpy as jnp
from jax import lax
import numpy as np

D_MODEL = 1024
BATCH = 32
SEQ = 2048
DEPTH = 2

N_EVEN = (DEPTH + 1) // 2
N_ODD = DEPTH // 2
RMS_EPS = 1e-6

MLA_HEADS = 8
MLA_NOPE = 64
MLA_ROPE = 32
MLA_V = 64
Q_LORA = 384
KV_LORA = 256
ROPE_BASE = 10000.0
Q_BLOCK = 128
MLA_OUT = MLA_HEADS * MLA_V
MLA_COLS = Q_LORA + KV_LORA + MLA_ROPE

RWKV_HEAD = 64
RWKV_DIM = D_MODEL // 2
RWKV_HEADS = RWKV_DIM // RWKV_HEAD
DECAY_LORA = 64
AAA_LORA = 64
GATE_LORA = 128
RWKV_GN_EPS = RWKV_HEAD * 1e-5
RWKV_COLS = 3 * RWKV_DIM + DECAY_LORA + AAA_LORA + GATE_LORA
IN_EVEN = MLA_COLS + RWKV_COLS
MIX_EVEN = MLA_OUT + RWKV_DIM

HG_K = 128
HG_HEADS = D_MODEL // HG_K
HG_V = D_MODEL // HG_HEADS
HG_QK_DIM = HG_HEADS * HG_K
HG_V_DIM = HG_HEADS * HG_V
HG_CHUNK = 32
IN_ODD = 2 * HG_QK_DIM + 2 * HG_V_DIM

FFN_HIDDEN = -(-8 * D_MODEL // (3 * 256)) * 256

kernel_name = 'hybrid_mla_rwkv7_hgrn2_adaln'


def rms_norm(x, gain, eps=RMS_EPS):
    xf = x.astype(jnp.float32)
    y = xf * lax.rsqrt(jnp.mean(xf * xf, axis=-1, keepdims=True) + eps)
    return (y * gain.astype(jnp.float32)).astype(x.dtype)


def modulate(h, shift, scale):
    return h * (1 + scale[:, None, :]) + shift[:, None, :]


def rope(x, cos, sin):
    x1, x2 = jnp.split(x, 2, axis=-1)
    return jnp.concatenate([x1 * cos - x2 * sin, x1 * sin + x2 * cos], axis=-1)


def mla_mix(p, positions, q_norm, w_uq, kv_norm, w_ukv):
    B, S, _ = p.shape
    c_q, c_kv, k_rope = jnp.split(p, [Q_LORA, Q_LORA + KV_LORA], axis=-1)
    q = (rms_norm(c_q, q_norm) @ w_uq).reshape(B, S, MLA_HEADS, MLA_NOPE + MLA_ROPE)
    q_nope, q_rope = q[..., :MLA_NOPE], q[..., MLA_NOPE:]
    kv = (rms_norm(c_kv, kv_norm) @ w_ukv).reshape(B, S, MLA_HEADS, MLA_NOPE + MLA_V)
    k_nope, v = kv[..., :MLA_NOPE], kv[..., MLA_NOPE:]
    inv_freq = 1.0 / (ROPE_BASE ** (jnp.arange(0, MLA_ROPE, 2, dtype=jnp.float32) / MLA_ROPE))
    ang = positions.astype(jnp.float32)[..., None] * inv_freq
    cos, sin = jnp.cos(ang).astype(p.dtype), jnp.sin(ang).astype(p.dtype)
    q_rope = rope(q_rope, cos[:, :, None, :], sin[:, :, None, :])
    k_rope = rope(k_rope, cos, sin)
    nb = S // Q_BLOCK
    qn_b = q_nope.reshape(B, nb, Q_BLOCK, MLA_HEADS, MLA_NOPE).transpose(1, 0, 2, 3, 4)
    qr_b = q_rope.reshape(B, nb, Q_BLOCK, MLA_HEADS, MLA_ROPE).transpose(1, 0, 2, 3, 4)
    scale = (MLA_NOPE + MLA_ROPE) ** -0.5
    kpos = jnp.arange(S)

    def block(args):
        i, qn, qr = args
        s = jnp.einsum('bqhd,bkhd->bhqk', qn, k_nope) + jnp.einsum('bqhr,bkr->bhqk', qr, k_rope)
        s = s.astype(jnp.float32) * scale
        qpos = i * Q_BLOCK + jnp.arange(Q_BLOCK)
        s = jnp.where(kpos[None, :] <= qpos[:, None], s, -jnp.inf)
        pr = jax.nn.softmax(s, axis=-1).astype(v.dtype)
        return jnp.einsum('bhqk,bkhd->bqhd', pr, v)

    o = lax.map(block, (jnp.arange(nb), qn_b, qr_b))
    return o.transpose(1, 0, 2, 3, 4).reshape(B, S, MLA_OUT)


def token_shift(p):
    return jnp.pad(p, ((0, 0), (1, 0), (0, 0)))[:, :-1]


def rwkv7_mix(p, mu, w0, w2, a0, a2, g2, k_k, k_a, r_k, ln_w, ln_b):
    B, S, _ = p.shape
    f32 = jnp.float32
    p = p + (token_shift(p) - p) * mu
    r, k, v, w_lo, a_lo, g_lo = jnp.split(
        p, [RWKV_DIM, 2 * RWKV_DIM, 3 * RWKV_DIM, 3 * RWKV_DIM + DECAY_LORA,
            3 * RWKV_DIM + DECAY_LORA + AAA_LORA], axis=-1)
    w_log = -jax.nn.softplus(-(w0 + jnp.tanh(w_lo) @ w2)) - 0.5
    decay = jnp.exp(-jnp.exp(w_log.astype(f32)))
    a = jax.nn.sigmoid(a0 + a_lo @ a2)
    g = jax.nn.sigmoid(g_lo) @ g2

    def heads(t):
        return t.reshape(B, S, RWKV_HEADS, RWKV_HEAD).astype(f32)

    kk = heads(k * k_k)
    kk = kk / jnp.maximum(jnp.linalg.norm(kk, axis=-1, keepdims=True), 1e-12)
    k = k * (1 + (a - 1) * k_a)
    r_h, k_h, v_h, w_h, a_h = heads(r), heads(k), heads(v), heads(decay), heads(a)

    def step(state, inp):
        r_t, w_t, k_t, v_t, kk_t, a_t = inp
        sa = jnp.einsum('bhvk,bhk->bhv', state, -kk_t)
        state = (state * w_t[:, :, None, :] + sa[..., None] * (kk_t * a_t)[:, :, None, :]
                 + v_t[..., None] * k_t[:, :, None, :])
        return state, jnp.einsum('bhvk,bhk->bhv', state, r_t)

    xs = tuple(t.transpose(1, 0, 2, 3) for t in (r_h, w_h, k_h, v_h, kk, a_h))
    state0 = jnp.zeros((B, RWKV_HEADS, RWKV_HEAD, RWKV_HEAD), f32)
    _, y = lax.scan(step, state0, xs)
    y = y.transpose(1, 0, 2, 3)
    mean = jnp.mean(y, axis=-1, keepdims=True)
    var = jnp.mean(jnp.square(y - mean), axis=-1, keepdims=True)
    y = (y - mean) * lax.rsqrt(var + RWKV_GN_EPS)
    y = y * ln_w.reshape(RWKV_HEADS, RWKV_HEAD) + ln_b.reshape(RWKV_HEADS, RWKV_HEAD)
    bonus = jnp.sum(r_h * k_h * r_k, axis=-1, keepdims=True) * v_h
    y = (y + bonus).reshape(B, S, RWKV_DIM) * g
    return y.astype(p.dtype)


def hgrn2_mix(p, lb, out_norm):
    B, S, _ = p.shape
    f32 = jnp.float32
    q, f, i, g = jnp.split(p, [HG_QK_DIM, 2 * HG_QK_DIM, 2 * HG_QK_DIM + HG_V_DIM], axis=-1)
    q = jax.nn.silu(q.astype(f32))
    forget = lb + (1 - lb) * jax.nn.sigmoid(f.astype(f32))
    key = 1 - forget
    logf = jnp.log(forget)
    nc = S // HG_CHUNK

    def chunks(t, d):
        return t.reshape(B, nc, HG_CHUNK, HG_HEADS, d).transpose(1, 0, 3, 2, 4)

    causal = jnp.tril(jnp.ones((HG_CHUNK, HG_CHUNK), bool))

    def step(state, inp):
        q_c, k_c, g_c, v_c = inp
        b = jnp.cumsum(g_c, axis=2)
        o_inter = jnp.einsum('bhck,bhkv->bhcv', q_c * jnp.exp(b), state)
        diff = b[:, :, :, None, :] - b[:, :, None, :, :]
        dec = jnp.exp(jnp.where(causal[:, :, None], diff, -jnp.inf))
        attn = jnp.einsum('bhtk,bhtsk,bhsk->bhts', q_c, dec, k_c)
        o = o_inter + jnp.einsum('bhts,bhsv->bhtv', attn, v_c)
        b_last = b[:, :, -1:, :]
        state = (state * jnp.exp(b_last[:, :, 0, :, None])
                 + jnp.einsum('bhsk,bhsv->bhkv', k_c * jnp.exp(b_last - b), v_c))
        return state, o

    xs = (chunks(q, HG_K), chunks(key, HG_K), chunks(logf, HG_K), chunks(i.astype(f32), HG_V))
    state0 = jnp.zeros((B, HG_HEADS, HG_K, HG_V), f32)
    _, o = lax.scan(step, state0, xs)
    o = o.transpose(1, 0, 3, 2, 4).reshape(B, S, HG_HEADS, HG_V)
    o = rms_norm(o, out_norm).reshape(B, S, HG_V_DIM) * jax.nn.silu(g.astype(f32))
    return o.astype(p.dtype)


def swiglu(h, w_gate, w_up, w_down):
    return (jax.nn.silu(h @ w_gate) * (h @ w_up)) @ w_down


def setup_inputs(seed: int = 0) -> dict:
    key = jax.random.key(seed)
    ks = iter(jax.random.split(key, 40))
    D = D_MODEL

    def nrm(shape, scale):
        return jax.random.normal(next(ks), shape, jnp.float32) * scale

    def gain(shape):
        return 1.0 + nrm(shape, 0.02)

    x = nrm((BATCH, SEQ, D), 1.0)
    c = nrm((BATCH, D), 1.0)
    offset = jax.random.randint(next(ks), (BATCH, 1), 0, 4096, dtype=jnp.int32)
    positions = offset + jnp.arange(SEQ, dtype=jnp.int32)[None, :]
    return {
        'x': x,
        'c': c,
        'positions': positions,
        'ada_w': nrm((DEPTH, D, 6 * D), 0.5 * D ** -0.5),
        'ada_b': nrm((DEPTH, 6 * D), 0.02),
        'norm_mix': gain((DEPTH, D)),
        'norm_ffn': gain((DEPTH, D)),
        'w_in_even': nrm((N_EVEN, D, IN_EVEN), D ** -0.5),
        'mla_q_norm': gain((N_EVEN, Q_LORA)),
        'mla_w_uq': nrm((N_EVEN, Q_LORA, MLA_HEADS * (MLA_NOPE + MLA_ROPE)), Q_LORA ** -0.5),
        'mla_kv_norm': gain((N_EVEN, KV_LORA)),
        'mla_w_ukv': nrm((N_EVEN, KV_LORA, MLA_HEADS * (MLA_NOPE + MLA_V)), KV_LORA ** -0.5),
        'rwkv_mu': jax.random.uniform(next(ks), (N_EVEN, RWKV_COLS), jnp.float32),
        'rwkv_w0': jax.random.uniform(next(ks), (N_EVEN, RWKV_DIM), jnp.float32, -6.0, -1.0),
        'rwkv_w2': nrm((N_EVEN, DECAY_LORA, RWKV_DIM), 0.5 * DECAY_LORA ** -0.5),
        'rwkv_a0': nrm((N_EVEN, RWKV_DIM), 0.1),
        'rwkv_a2': nrm((N_EVEN, AAA_LORA, RWKV_DIM), 0.5 * AAA_LORA ** -0.5),
        'rwkv_g2': nrm((N_EVEN, GATE_LORA, RWKV_DIM), GATE_LORA ** -0.5),
        'rwkv_k_k': 0.85 + nrm((N_EVEN, RWKV_DIM), 0.05),
        'rwkv_k_a': 1.0 + nrm((N_EVEN, RWKV_DIM), 0.05),
        'rwkv_r_k': nrm((N_EVEN, RWKV_HEADS, RWKV_HEAD), 0.1),
        'rwkv_ln_w': gain((N_EVEN, RWKV_DIM)),
        'rwkv_ln_b': nrm((N_EVEN, RWKV_DIM), 0.02),
        'w_out_even': nrm((N_EVEN, MIX_EVEN, D), MIX_EVEN ** -0.5),
        'w_in_odd': nrm((N_ODD, D, IN_ODD), D ** -0.5),
        'hg_lb_logits': nrm((DEPTH, HG_QK_DIM), 0.5),
        'hg_out_norm': gain((N_ODD, HG_V)),
        'w_out_odd': nrm((N_ODD, HG_V_DIM, D), HG_V_DIM ** -0.5),
        'ffn_w_gate': nrm((DEPTH, D, FFN_HIDDEN), D ** -0.5),
        'ffn_w_up': nrm((DEPTH, D, FFN_HIDDEN), D ** -0.5),
        'ffn_w_down': nrm((DEPTH, FFN_HIDDEN, D), FFN_HIDDEN ** -0.5),
        'final_norm': gain((D,)),
    }


def reference(x, c, positions, ada_w, ada_b, norm_mix, norm_ffn, w_in_even, mla_q_norm, mla_w_uq,
              mla_kv_norm, mla_w_ukv, rwkv_mu, rwkv_w0, rwkv_w2, rwkv_a0, rwkv_a2, rwkv_g2, rwkv_k_k,
              rwkv_k_a, rwkv_r_k, rwkv_ln_w, rwkv_ln_b, w_out_even, w_in_odd, hg_lb_logits, hg_out_norm,
              w_out_odd, ffn_w_gate, ffn_w_up, ffn_w_down, final_norm):
    cond = jax.nn.silu(c)
    lb_p = jax.nn.softmax(hg_lb_logits.astype(jnp.float32), axis=0)
    lb_all = jnp.cumsum(lb_p, axis=0) - lb_p[0]
    for l in range(DEPTH):
        mod = cond @ ada_w[l] + ada_b[l]
        sh_m, sc_m, g_m, sh_f, sc_f, g_f = jnp.split(mod, 6, axis=-1)
        h = modulate(rms_norm(x, norm_mix[l]), sh_m, sc_m)
        j = l // 2
        if l % 2 == 0:
            proj = h @ w_in_even[j]
            y_a = mla_mix(proj[..., :MLA_COLS], positions, mla_q_norm[j], mla_w_uq[j],
                          mla_kv_norm[j], mla_w_ukv[j])
            y_b = rwkv7_mix(proj[..., MLA_COLS:], rwkv_mu[j], rwkv_w0[j], rwkv_w2[j], rwkv_a0[j],
                            rwkv_a2[j], rwkv_g2[j], rwkv_k_k[j], rwkv_k_a[j], rwkv_r_k[j],
                            rwkv_ln_w[j], rwkv_ln_b[j])
            y = jnp.concatenate([y_a, y_b], axis=-1) @ w_out_even[j]
        else:
            y = hgrn2_mix(h @ w_in_odd[j], lb_all[l], hg_out_norm[j]) @ w_out_odd[j]
        x = x + g_m[:, None, :] * y
        h = modulate(rms_norm(x, norm_ffn[l]), sh_f, sc_f)
        x = x + g_f[:, None, :] * swiglu(h, ffn_w_gate[l], ffn_w_up[l], ffn_w_down[l])
    return rms_norm(x, final_norm)
```

```cpp
#include <hip/hip_runtime.h>
#include <hip/hip_cooperative_groups.h>
#include <cstdio>
#include <cstdint>
namespace cg = cooperative_groups;

#define LAS __attribute__((address_space(3)))
typedef unsigned short bf16_t;
typedef short bf16x8 __attribute__((ext_vector_type(8)));
typedef float f32x4 __attribute__((ext_vector_type(4)));
typedef float f32x2 __attribute__((ext_vector_type(2)));
typedef float f32x16 __attribute__((ext_vector_type(16)));
typedef unsigned u32x4 __attribute__((ext_vector_type(4)));
typedef unsigned u32x2 __attribute__((ext_vector_type(2)));
typedef __bf16 bf16x2_t __attribute__((ext_vector_type(2)));

constexpr int D = 1024, NB = 32, S = 2048, T = NB * S;
constexpr int IN_EVEN = 2464, IN_EVEN_P = 2560, RW_OFF = 672;
constexpr int FF = 2816, IN_ODD = 4096;
constexpr int NTHREADS = 512, NWAVES = 8;
constexpr int LDS_BYTES = 147456;
constexpr float QSCALE = 0.10206207261596577f * 1.4426950408889634f;

constexpr size_t MiB = 1u << 20;
constexpr size_t WS_MOD = 0;
constexpr size_t WS_LB = 2 * MiB;
constexpr size_t WS_BAR = 3 * MiB;
constexpr size_t WS_WINE = 4 * MiB;
constexpr size_t WS_WUQ = 9 * MiB;
constexpr size_t WS_WUKV = 10 * MiB;
constexpr size_t WS_WLORA = 11 * MiB;
constexpr size_t WS_WOUTE = 12 * MiB;
constexpr size_t WS_WINO = 14 * MiB;
constexpr size_t WS_WOUTO = 22 * MiB;
constexpr size_t WS_WGU = 24 * MiB;
constexpr size_t WS_WD = 46 * MiB;
constexpr size_t WS_STATS = 57 * MiB;
constexpr size_t WS_CS = 58 * MiB;
constexpr size_t WS_HB = 66 * MiB;
constexpr size_t WS_BIG = 194 * MiB;
constexpr size_t WS_Q = 514 * MiB;
constexpr size_t WS_KH = 610 * MiB;
constexpr size_t WS_KR = 674 * MiB;
constexpr size_t WS_VH = 706 * MiB;
constexpr size_t WS_AP = 770 * MiB;
constexpr size_t WS_LORA = 802 * MiB;
constexpr size_t WS_XF = 706 * MiB;
constexpr size_t WS_END = 994 * MiB;

__device__ __forceinline__ float bf2f(bf16_t v) { return __uint_as_float(((unsigned)v) << 16); }
__device__ __forceinline__ unsigned pk2(float lo, float hi) { f32x2 v = {lo, hi}; bf16x2_t b = __builtin_convertvector(v, bf16x2_t); return __builtin_bit_cast(unsigned, b); }
__device__ __forceinline__ bf16_t f2bf(float f) { return (bf16_t)(pk2(f, 0.f) & 0xffffu); }
__device__ __forceinline__ float sigmoidf_(float x) { return __builtin_amdgcn_rcpf(1.f + __expf(-x)); }
__device__ __forceinline__ float siluf_(float x) { return x * sigmoidf_(x); }
__device__ __forceinline__ float wave_sum(float v) {
#pragma unroll
    for (int o = 1; o < 64; o <<= 1) v += __shfl_xor(v, o);
    return v;
}
__device__ __forceinline__ float rl_(float x, int l) { return __int_as_float(__builtin_amdgcn_readlane(__float_as_int(x), l)); }
template <int CTRL> __device__ __forceinline__ float dpp_f(float x) { return __int_as_float(__builtin_amdgcn_mov_dpp(__float_as_int(x), CTRL, 0xf, 0xf, true)); }
__device__ __forceinline__ float reduce16(float x) {
    x += dpp_f<0xB1>(x);
    x += dpp_f<0x4E>(x);
    x += dpp_f<0x141>(x);
    x += dpp_f<0x140>(x);
    return x;
}

__device__ __forceinline__ int lane_id_() { int l; asm volatile("v_mbcnt_lo_u32_b32 %0, -1, 0\n\tv_mbcnt_hi_u32_b32 %0, -1, %0" : "=v"(l)); return l; }
__device__ __forceinline__ float wave_sum_fast(float x) { x = reduce16(x); return (rl_(x, 0) + rl_(x, 16)) + (rl_(x, 32) + rl_(x, 48)); }
namespace pg8 {
constexpr int BM = 256, BK = 64, HALF = 128, HTB = HALF * BK * 2, STAGE_BYTES = 8 * HTB, NXCD = 8, WGM = 8;
__host__ __device__ __forceinline__ int lds_byte(int r, int c) { const int st = (r >> 4) * 2 + (c >> 5), rr = r & 15, cc = c & 31, ob = rr * 64 + cc * 2; return st * 1024 + (ob ^ (((ob >> 9) & 1) << 5)); }
__host__ __device__ __forceinline__ void stage_rc(int b, int& R, int& C) { const int st = b / 1024, sb = b % 1024, swz = sb ^ (((sb >> 9) & 1) << 5); R = (st >> 1) * 16 + swz / 64; C = (st & 1) * 32 + (swz % 64) / 2; }
__host__ __device__ __forceinline__ int perm32(int rho) { const int n = rho >> 4, i = rho & 15; return 8 * (i >> 2) + 4 * n + (i & 3); }
struct Unit { int pm, pn; };
struct Gemm { const bf16_t* A; const bf16_t* Bt; };
struct StaticOrder {
    int nM, nN, nwg, G, c;
    __device__ void init(int M, int N, int G_, int c_) { nM = M / BM; nN = N / BM; nwg = nM * nN; G = G_; c = c_; }
    __device__ bool next(int i, Unit& u) const {
        const long L = (long)i * G + c; if (L >= nwg) return false;
        int wgid = (int)L; { const int q = nwg / NXCD, r = nwg % NXCD, xcd = wgid % NXCD, off = wgid / NXCD; wgid = (xcd < r ? xcd * (q + 1) : r * (q + 1) + (xcd - r) * q) + off; }
        const int nig = WGM * nN, gid = wgid / nig, fm = gid * WGM, gsz = (nM - fm) < WGM ? (nM - fm) : WGM;
        u.pm = fm + ((wgid % nig) % gsz); u.pn = (wgid % nig) / gsz; return true;
    }
};
template <class Epi, bool ALIGN_EPI, int K, int LDA, int LDB>
__device__ __forceinline__ void gemm_phase(LAS unsigned char* lds, const int wid, const Gemm g, const StaticOrder& S, const Epi& E) {
    const int lane = lane_id_(), tid = wid * 64 + lane, wr = wid >> 2, wc = wid & 3, fr = lane & 15, fq = lane >> 4;
    constexpr int nt = K / BK;
    unsigned voffA[2], voffB[2];
#pragma unroll
    for (int i = 0; i < 2; ++i) { int R, C; stage_rc(tid * 16 + i * 8192, R, C); const int Rb = Epi::PERM ? ((R & ~31) + perm32(R & 31)) : R;
        voffA[i] = (unsigned)(R * LDA + C) * 2u; voffB[i] = (unsigned)(Rb * LDB + C) * 2u; }
    constexpr size_t kstep = (size_t)(BK * 2);
    constexpr size_t hA = (size_t)HALF * LDA * 2, hB = (size_t)HALF * LDB * 2;
    constexpr size_t tA = 2 * hA, tB = 2 * hB;
    const unsigned ldsw = (unsigned)wid * 1024u;
    const int aoff = lds_byte(wr * 64 + fr, fq * 8), boff = lds_byte(wc * 32 + fr, fq * 8);
#define PG8_SA(b, h) (((b) * 2 + (h)) * HTB)
#define PG8_SB(b, h) ((4 + (b) * 2 + (h)) * HTB)
#define PG8_STAGE(bufoff, gbase, voff) do { _Pragma("unroll") for (int _i = 0; _i < 2; ++_i) \
        __builtin_amdgcn_global_load_lds((const unsigned*)((const char*)(gbase) + (voff)[_i]), (LAS unsigned*)(lds + (bufoff) + ldsw + _i * 8192), 16, 0, 0); } while (0)
#define PG8_LDA(dst, b, h) do { _Pragma("unroll") for (int m = 0; m < 4; ++m) _Pragma("unroll") for (int k = 0; k < 2; ++k) dst[m][k] = *(const LAS bf16x8*)(lds + PG8_SA(b, h) + aoff + m * 2048 + k * 1024); } while (0)
#define PG8_LDB(dst, b, h) do { _Pragma("unroll") for (int n = 0; n < 2; ++n) _Pragma("unroll") for (int k = 0; k < 2; ++k) dst[n][k] = *(const LAS bf16x8*)(lds + PG8_SB(b, h) + boff + n * 2048 + k * 1024); } while (0)
#define PG8_MMA(ai, bj, At, Bt) do { __builtin_amdgcn_s_setprio(1); _Pragma("unroll") for (int m = 0; m < 4; ++m) _Pragma("unroll") for (int n = 0; n < 2; ++n) _Pragma("unroll") for (int k = 0; k < 2; ++k) \
        acc[ai][bj][m][n] = __builtin_amdgcn_mfma_f32_16x16x32_bf16(Bt[n][k], At[m][k], acc[ai][bj][m][n], 0, 0, 0); __builtin_amdgcn_s_setprio(0); } while (0)
#define PG8_WAIT_V(n) asm volatile("s_waitcnt vmcnt(" #n ")" ::: "memory")
#define PG8_WAIT_L(n) asm volatile("s_waitcnt lgkmcnt(" #n ")" ::: "memory")
#define PG8_BAR __builtin_amdgcn_s_barrier()
#define PG8_SCHED __builtin_amdgcn_sched_barrier(0)
    Unit cur, nxt; int ui = 0;
    if (!S.next(0, cur)) return;
    f32x4 acc[2][2][4][2];
#pragma unroll
    for (int a = 0; a < 2; ++a)
#pragma unroll
        for (int b = 0; b < 2; ++b)
#pragma unroll
            for (int m = 0; m < 4; ++m)
#pragma unroll
                for (int n = 0; n < 2; ++n) acc[a][b][m][n] = (f32x4){0.f, 0.f, 0.f, 0.f};
    bf16x8 At[4][2], B0[2][2], B1[2][2];
    const char* cA = (const char*)g.A + (size_t)cur.pm * tA; const char* cB = (const char*)g.Bt + (size_t)cur.pn * tB;
    PG8_STAGE(PG8_SB(0, 0), cB, voffB); PG8_STAGE(PG8_SB(0, 1), cB + hB, voffB); PG8_STAGE(PG8_SA(0, 0), cA, voffA); PG8_STAGE(PG8_SA(0, 1), cA + hA, voffA);
    if (wr == 1) PG8_BAR;
    PG8_WAIT_V(2); PG8_BAR;
    PG8_STAGE(PG8_SB(1, 0), cB + kstep, voffB); PG8_STAGE(PG8_SA(1, 0), cA + kstep, voffA); PG8_STAGE(PG8_SB(1, 1), cB + hB + kstep, voffB);
    PG8_WAIT_V(6); PG8_BAR;
    for (;;) {
        const bool has_next = S.next(ui + 1, nxt);
        const char* nA = has_next ? (const char*)g.A + (size_t)nxt.pm * tA : cA; const char* nB = has_next ? (const char*)g.Bt + (size_t)nxt.pn * tB : cB;
        for (int t = 0; t < nt; t += 2) {
            const bool last = (t == nt - 2);
            const char* a1 = cA + (size_t)(t + 1) * kstep;
            const char* a2 = last ? nA : cA + (size_t)(t + 2) * kstep; const char* b2 = last ? nB : cB + (size_t)(t + 2) * kstep;
            const char* a3 = a2 + kstep; const char* b3 = b2 + kstep;
            PG8_LDB(B0, 0, 0); PG8_LDB(B1, 0, 1); PG8_SCHED; PG8_LDA(At, 0, 0); PG8_STAGE(PG8_SA(1, 1), a1 + hA, voffA);
            PG8_WAIT_V(8); PG8_WAIT_L(0); PG8_BAR; PG8_MMA(0, 0, At, B0); PG8_MMA(0, 1, At, B1); PG8_BAR; PG8_SCHED;
            PG8_LDA(At, 0, 1); PG8_STAGE(PG8_SB(0, 0), b2, voffB); PG8_STAGE(PG8_SB(0, 1), b2 + hB, voffB); PG8_STAGE(PG8_SA(0, 0), a2, voffA);
            PG8_WAIT_V(8); PG8_WAIT_L(0); PG8_BAR; PG8_MMA(1, 0, At, B0); PG8_MMA(1, 1, At, B1); PG8_BAR; PG8_SCHED;
            PG8_LDB(B0, 1, 0); PG8_LDB(B1, 1, 1); PG8_SCHED; PG8_LDA(At, 1, 0); PG8_STAGE(PG8_SA(0, 1), a2 + hA, voffA);
            PG8_WAIT_V(8); PG8_WAIT_L(0); PG8_BAR; PG8_MMA(0, 0, At, B0); PG8_MMA(0, 1, At, B1); PG8_BAR; PG8_SCHED;
            PG8_LDA(At, 1, 1); PG8_STAGE(PG8_SB(1, 0), b3, voffB); PG8_STAGE(PG8_SB(1, 1), b3 + hB, voffB); PG8_STAGE(PG8_SA(1, 0), a3, voffA);
            PG8_WAIT_V(8); PG8_WAIT_L(0); PG8_BAR; PG8_MMA(1, 0, At, B0); PG8_MMA(1, 1, At, B1); PG8_BAR; PG8_SCHED;
        }
        if constexpr (ALIGN_EPI) { if (wr == 0) PG8_BAR; }
        { const int l2 = lane_id_(); E(acc, cur, wid >> 2, wid & 3, l2 & 15, l2 >> 4); }
        if (!has_next) break;
#pragma unroll
        for (int a = 0; a < 2; ++a)
#pragma unroll
            for (int b = 0; b < 2; ++b)
#pragma unroll
                for (int m = 0; m < 4; ++m)
#pragma unroll
                    for (int n = 0; n < 2; ++n) acc[a][b][m][n] = (f32x4){0.f, 0.f, 0.f, 0.f};
        cur = nxt; cA = nA; cB = nB; ++ui;
        if constexpr (ALIGN_EPI) { if (wr == 1) PG8_BAR; }
    }
    PG8_WAIT_V(0);
    if constexpr (!ALIGN_EPI) { if (wr == 0) PG8_BAR; }
    PG8_BAR;
#undef PG8_SA
#undef PG8_SB
#undef PG8_STAGE
#undef PG8_LDA
#undef PG8_LDB
#undef PG8_MMA
#undef PG8_WAIT_V
#undef PG8_WAIT_L
#undef PG8_BAR
#undef PG8_SCHED
}

struct EpiBf16 {
    static constexpr bool PERM = true;
    bf16_t* O; int ldc;
    __device__ __forceinline__ void operator()(const f32x4 (&acc)[2][2][4][2], const Unit& u, int wr, int wc, int fr, int fq) const {
        const int row0 = u.pm * BM + wr * 64 + fr, col0 = u.pn * BM + wc * 32 + 8 * fq;
#pragma unroll
        for (int ai = 0; ai < 2; ++ai)
#pragma unroll
            for (int m = 0; m < 4; ++m) { bf16_t* rowp = O + (size_t)(row0 + ai * HALF + m * 16) * ldc + col0;
#pragma unroll
                for (int bj = 0; bj < 2; ++bj) { const f32x4 v0 = acc[ai][bj][m][0], v1 = acc[ai][bj][m][1];
                    u32x4 w; w.x = pk2(v0[0], v0[1]); w.y = pk2(v0[2], v0[3]); w.z = pk2(v1[0], v1[1]); w.w = pk2(v1[2], v1[3]);
                    *(u32x4*)(rowp + bj * HALF) = w; } }
    }
};
struct EpiOdd {
    static constexpr bool PERM = true;
    bf16_t* O;
    __device__ __forceinline__ void operator()(const f32x4 (&acc)[2][2][4][2], const Unit& u, int wr, int wc, int fr, int fq) const {
        const int row0 = u.pm * BM + wr * 64 + fr, col0 = u.pn * BM + wc * 32 + 8 * fq; const bool act = (u.pn < 4) || (u.pn >= 12);
#pragma unroll
        for (int ai = 0; ai < 2; ++ai)
#pragma unroll
            for (int m = 0; m < 4; ++m) { bf16_t* rowp = O + (size_t)(row0 + ai * HALF + m * 16) * IN_ODD + col0;
#pragma unroll
                for (int bj = 0; bj < 2; ++bj) { f32x4 v0 = acc[ai][bj][m][0], v1 = acc[ai][bj][m][1];
                    if (act) {
#pragma unroll
                        for (int j = 0; j < 4; ++j) { v0[j] = siluf_(v0[j]); v1[j] = siluf_(v1[j]); } }
                    u32x4 w; w.x = pk2(v0[0], v0[1]); w.y = pk2(v0[2], v0[3]); w.z = pk2(v1[0], v1[1]); w.w = pk2(v1[2], v1[3]);
                    *(u32x4*)(rowp + bj * HALF) = w; } }
    }
};
struct EpiKV {
    static constexpr bool PERM = true;
    bf16_t* Kh; bf16_t* Vh; const float* stats;
    __device__ __forceinline__ void operator()(const f32x4 (&acc)[2][2][4][2], const Unit& u, int wr, int wc, int fr, int fq) const {
        const int row0 = u.pm * BM + wr * 64 + fr;
        float scv[2][4];
#pragma unroll
        for (int ai = 0; ai < 2; ++ai)
#pragma unroll
            for (int m = 0; m < 4; ++m) scv[ai][m] = stats[2 * (row0 + ai * HALF + m * 16) + 1];
#pragma unroll
        for (int ai = 0; ai < 2; ++ai)
#pragma unroll
            for (int m = 0; m < 4; ++m) { const int row = row0 + ai * HALF + m * 16; const int b = row / S, s = row % S; const float sc = scv[ai][m];
#pragma unroll
                for (int bj = 0; bj < 2; ++bj) { const int h = 2 * u.pn + bj; const f32x4 v0 = acc[ai][bj][m][0] * sc, v1 = acc[ai][bj][m][1] * sc;
                    u32x4 w; w.x = pk2(v0[0], v0[1]); w.y = pk2(v0[2], v0[3]); w.z = pk2(v1[0], v1[1]); w.w = pk2(v1[2], v1[3]);
                    const size_t tok = (size_t)(b * 8 + h) * S + s;
                    if (wc < 2) *(u32x4*)(Kh + tok * 64 + wc * 32 + 8 * fq) = w;
                    else        *(u32x4*)(Vh + tok * 64 + (wc - 2) * 32 + 8 * fq) = w; } }
    }
};
struct EpiQ {
    static constexpr bool PERM = false;
    bf16_t* Q; const float* stats; const float* cs;
    __device__ __forceinline__ void operator()(const f32x4 (&acc)[2][2][4][2], const Unit& u, int wr, int wc, int fr, int fq) const {
        const int row0 = u.pm * BM + wr * 64 + fr;
        float scv[2][4];
#pragma unroll
        for (int ai = 0; ai < 2; ++ai)
#pragma unroll
            for (int m = 0; m < 4; ++m) scv[ai][m] = stats[2 * (row0 + ai * HALF + m * 16)];
#pragma unroll
        for (int ai = 0; ai < 2; ++ai)
#pragma unroll
            for (int m = 0; m < 4; ++m) { const int row = row0 + ai * HALF + m * 16; const float sc = scv[ai][m] * QSCALE;
                const f32x4 cv = *(const f32x4*)(cs + (size_t)row * 32 + 4 * fq), sv = *(const f32x4*)(cs + (size_t)row * 32 + 16 + 4 * fq);
#pragma unroll
                for (int bj = 0; bj < 2; ++bj) { const int g = 8 * u.pn + 4 * bj + wc; const bool rp = (g % 3) == 2;
                    f32x4 x1 = acc[ai][bj][m][0] * sc, x2 = acc[ai][bj][m][1] * sc;
                    if (rp) { const f32x4 o1 = x1 * cv - x2 * sv, o2 = x1 * sv + x2 * cv; x1 = o1; x2 = o2; }
                    bf16_t* p = Q + (size_t)row * 768 + g * 32 + 4 * fq;
                    u32x2 w0, w1; w0.x = pk2(x1[0], x1[1]); w0.y = pk2(x1[2], x1[3]); w1.x = pk2(x2[0], x2[1]); w1.y = pk2(x2[2], x2[3]);
                    *(u32x2*)p = w0; *(u32x2*)(p + 16) = w1; } }
    }
};
template <bool BASE_BF16> struct EpiRes {
    static constexpr bool PERM = true;
    const void* base; bf16_t* out; const float* gate;
    __device__ __forceinline__ void operator()(const f32x4 (&acc)[2][2][4][2], const Unit& u, int wr, int wc, int fr, int fq) const {
        const int row0 = u.pm * BM + wr * 64 + fr; const int b = (u.pm * BM) / S;
        f32x4 gv[2][2];
#pragma unroll
        for (int bj = 0; bj < 2; ++bj)
#pragma unroll
            for (int n = 0; n < 2; ++n) gv[bj][n] = *(const f32x4*)(gate + (size_t)b * 6144 + u.pn * BM + bj * HALF + wc * 32 + 8 * fq + 4 * n);
#pragma unroll
        for (int ai = 0; ai < 2; ++ai)
#pragma unroll
            for (int m = 0; m < 4; ++m) { const size_t off = (size_t)(row0 + ai * HALF + m * 16) * D + u.pn * BM + wc * 32 + 8 * fq;
#pragma unroll
                for (int bj = 0; bj < 2; ++bj) { const size_t o = off + bj * HALF; f32x4 b0, b1;
                    if (BASE_BF16) { const u32x4 r = *(const u32x4*)((const bf16_t*)base + o);
                        b0 = (f32x4){__uint_as_float(r.x << 16), __uint_as_float(r.x & 0xffff0000u), __uint_as_float(r.y << 16), __uint_as_float(r.y & 0xffff0000u)};
                        b1 = (f32x4){__uint_as_float(r.z << 16), __uint_as_float(r.z & 0xffff0000u), __uint_as_float(r.w << 16), __uint_as_float(r.w & 0xffff0000u)}; }
                    else { b0 = *(const f32x4*)((const float*)base + o); b1 = *(const f32x4*)((const float*)base + o + 4); }
                    const f32x4 v0 = b0 + gv[bj][0] * acc[ai][bj][m][0], v1 = b1 + gv[bj][1] * acc[ai][bj][m][1];
                    u32x4 w; w.x = pk2(v0[0], v0[1]); w.y = pk2(v0[2], v0[3]); w.z = pk2(v1[0], v1[1]); w.w = pk2(v1[2], v1[3]);
                    *(u32x4*)(out + o) = w; } }
    }
};
struct EpiSwiglu {
    static constexpr bool PERM = true;
    bf16_t* H;
    __device__ __forceinline__ void operator()(const f32x4 (&acc)[2][2][4][2], const Unit& u, int wr, int wc, int fr, int fq) const {
        const int row0 = u.pm * BM + wr * 64 + fr, col0 = u.pn * HALF + wc * 32 + 8 * fq;
#pragma unroll
        for (int ai = 0; ai < 2; ++ai)
#pragma unroll
            for (int m = 0; m < 4; ++m) { float v[8];
#pragma unroll
                for (int n = 0; n < 2; ++n)
#pragma unroll
                    for (int j = 0; j < 4; ++j) { const float gt = acc[ai][0][m][n][j], up = acc[ai][1][m][n][j]; v[4 * n + j] = siluf_(gt) * up; }
                u32x4 w; w.x = pk2(v[0], v[1]); w.y = pk2(v[2], v[3]); w.z = pk2(v[4], v[5]); w.w = pk2(v[6], v[7]);
                *(u32x4*)(H + (size_t)(row0 + ai * HALF + m * 16) * FF + col0) = w; }
    }
};
}

struct Args { const void* in[32]; float* out; unsigned char* ws; int ph_lo, ph_hi; };

struct Ctx {
    LAS unsigned char* lds; int G, bid, wid;
    const __attribute__((address_space(4))) unsigned long long* in;
    float* out; unsigned char* ws;
};
#define INF(i) ((const float*)F.in[i])
#define F_x INF(0)
#define F_c INF(1)
#define F_pos ((const int*)F.in[2])
#define F_ada_w INF(3)
#define F_ada_b INF(4)
#define F_norm_mix INF(5)
#define F_norm_ffn INF(6)
#define F_w_in_even INF(7)
#define F_q_norm INF(8)
#define F_w_uq INF(9)
#define F_kv_norm INF(10)
#define F_w_ukv INF(11)
#define F_mu INF(12)
#define F_w0 INF(13)
#define F_w2 INF(14)
#define F_a0 INF(15)
#define F_a2 INF(16)
#define F_g2 INF(17)
#define F_k_k INF(18)
#define F_k_a INF(19)
#define F_r_k INF(20)
#define F_ln_w INF(21)
#define F_ln_b INF(22)
#define F_w_out_even INF(23)
#define F_w_in_odd INF(24)
#define F_lb_logits INF(25)
#define F_hg_norm INF(26)
#define F_w_out_odd INF(27)
#define F_w_gate INF(28)
#define F_w_up INF(29)
#define F_w_down INF(30)
#define F_final_norm INF(31)

__device__ __forceinline__ void tr_item(const float* W, int K, int N, bf16_t* WT, int ldt, int rowmode, const float* ksc, LAS float* scr, int item, int lane) {
    const int nblk = N / 32, kb = item / nblk, nb = item % nblk, k0 = 64 * kb, n0 = 32 * nb;
#pragma unroll 8
    for (int i = 0; i < 32; ++i) { const int kk = 2 * i + (lane >> 5); float v = W[(size_t)(k0 + kk) * N + n0 + (lane & 31)]; if (ksc) v *= ksc[k0 + kk]; scr[kk * 33 + (lane & 31)] = v; }
    asm volatile("s_waitcnt lgkmcnt(0)" ::: "memory");
    const int c = lane & 7;
#pragma unroll
    for (int j = 0; j < 4; ++j) { const int n = n0 + (lane >> 3) + 8 * j; const LAS float* s = scr + (8 * c) * 33 + (lane >> 3) + 8 * j;
        u32x4 o; o.x = pk2(s[0 * 33], s[1 * 33]); o.y = pk2(s[2 * 33], s[3 * 33]); o.z = pk2(s[4 * 33], s[5 * 33]); o.w = pk2(s[6 * 33], s[7 * 33]);
        int row = n; if (rowmode) row = (n >> 7) * 256 + (n & 127) + (rowmode == 2 ? 128 : 0);
        *(u32x4*)(WT + (size_t)row * ldt + k0 + 8 * c) = o; }
    asm volatile("s_waitcnt lgkmcnt(0)" ::: "memory");
}

__device__ __forceinline__ void p0_prologue(const Ctx& F) {
    float* mod = (float*)(F.ws + WS_MOD);
    for (int it = F.bid; it < 192; it += F.G) {
        const int l = it / 96, n0 = (it % 96) * 64;
        LAS float* cs = (LAS float*)F.lds;
        for (int e = (F.wid * 64 + lane_id_()); e < 32768; e += NTHREADS) { const int k = e >> 5, b = e & 31; cs[e] = siluf_(F_c[b * 1024 + k]); }
        __syncthreads();
        const int n = (F.wid * 64 + lane_id_()) & 63, kp = (F.wid * 64 + lane_id_()) >> 6;
        float acc[32];
#pragma unroll
        for (int b = 0; b < 32; ++b) acc[b] = 0.f;
        const float* wp = F_ada_w + ((size_t)l * 1024 + kp * 128) * 6144 + n0 + n;
        for (int k8 = 0; k8 < 128; k8 += 8) {
            float wv[8];
#pragma unroll
            for (int u = 0; u < 8; ++u) wv[u] = wp[(size_t)(k8 + u) * 6144];
#pragma unroll
            for (int u = 0; u < 8; ++u) { const float w = wv[u]; const LAS f32x4* cr = (const LAS f32x4*)(cs + (kp * 128 + k8 + u) * 32);
#pragma unroll
                for (int b4 = 0; b4 < 8; ++b4) { const f32x4 cv = cr[b4]; acc[4 * b4] += cv[0] * w; acc[4 * b4 + 1] += cv[1] * w; acc[4 * b4 + 2] += cv[2] * w; acc[4 * b4 + 3] += cv[3] * w; } }
        }
        __syncthreads();
        LAS float* red = (LAS float*)F.lds;
#pragma unroll
        for (int b = 0; b < 32; ++b) red[(kp * 32 + b) * 64 + n] = acc[b];
        __syncthreads();
#pragma unroll
        for (int i = 0; i < 4; ++i) { const int o = (F.wid * 64 + lane_id_()) + NTHREADS * i, b = o >> 6, nn = o & 63; float s = F_ada_b[l * 6144 + n0 + nn];
#pragma unroll
            for (int p = 0; p < 8; ++p) s += red[(p * 32 + b) * 64 + nn];
            mod[((size_t)l * 32 + b) * 6144 + n0 + nn] = s; }
        __syncthreads();
    }
    {
        LAS float* scr = (LAS float*)(F.lds + F.wid * 16384);
        const int gw = F.bid * NWAVES + F.wid, NGW = F.G * NWAVES;
        bf16_t* WinE = (bf16_t*)(F.ws + WS_WINE); bf16_t* Wuq = (bf16_t*)(F.ws + WS_WUQ); bf16_t* Wukv = (bf16_t*)(F.ws + WS_WUKV);
        bf16_t* WoutE = (bf16_t*)(F.ws + WS_WOUTE); bf16_t* WinO = (bf16_t*)(F.ws + WS_WINO); bf16_t* WoutO = (bf16_t*)(F.ws + WS_WOUTO);
        bf16_t* Wgu = (bf16_t*)(F.ws + WS_WGU); bf16_t* Wd = (bf16_t*)(F.ws + WS_WD);
        constexpr int I1 = 16 * 77, I2 = 6 * 24, I3 = 4 * 32, I4 = 16 * 32, I5 = 16 * 128, I6 = 16 * 32, I7 = 16 * 88, I9 = 44 * 32;
        constexpr int NIT = I1 + I2 + I3 + I4 + I5 + I6 + 4 * I7 + 2 * I9;
        for (int it = gw; it < NIT; it += NGW) {
            int r = it;
            if (r < I1) { tr_item(F_w_in_even, 1024, IN_EVEN, WinE, 1024, 0, nullptr, scr, r, lane_id_()); continue; } r -= I1;
            if (r < I2) { tr_item(F_w_uq, 384, 768, Wuq, 384, 0, F_q_norm, scr, r, lane_id_()); continue; } r -= I2;
            if (r < I3) { tr_item(F_w_ukv, 256, 1024, Wukv, 256, 0, F_kv_norm, scr, r, lane_id_()); continue; } r -= I3;
            if (r < I4) { tr_item(F_w_out_even, 1024, 1024, WoutE, 1024, 0, nullptr, scr, r, lane_id_()); continue; } r -= I4;
            if (r < I5) { tr_item(F_w_in_odd, 1024, 4096, WinO, 1024, 0, nullptr, scr, r, lane_id_()); continue; } r -= I5;
            if (r < I6) { tr_item(F_w_out_odd, 1024, 1024, WoutO, 1024, 0, nullptr, scr, r, lane_id_()); continue; } r -= I6;
            if (r < 4 * I7) { const int q = r / I7, l = q >> 1, up = q & 1; r -= q * I7;
                tr_item((up ? F_w_up : F_w_gate) + (size_t)l * 1024 * FF, 1024, FF, Wgu + (size_t)l * 5632 * 1024, 1024, 1 + up, nullptr, scr, r, lane_id_()); continue; } r -= 4 * I7;
            { const int l = r / I9; r -= l * I9; tr_item(F_w_down + (size_t)l * FF * 1024, FF, 1024, Wd + (size_t)l * 1024 * FF, FF, 0, nullptr, scr, r, lane_id_()); }
        }
    }
    {
        const size_t gt = (size_t)F.bid * NTHREADS + (F.wid * 64 + lane_id_()), NGT = (size_t)F.G * NTHREADS;
        bf16_t* WinE = (bf16_t*)(F.ws + WS_WINE); bf16_t* Wl = (bf16_t*)(F.ws + WS_WLORA); float* lb = (float*)(F.ws + WS_LB);
        for (size_t e = gt; e < (size_t)96 * 1024; e += NGT) WinE[(size_t)IN_EVEN * 1024 + e] = 0;
        for (size_t e = gt; e < (size_t)1536 * 256; e += NGT) { const int n = (int)(e >> 8), k = (int)(e & 255); float v = 0.f;
            if (n < 512) { if (k < 64) v = F_w2[k * 512 + n]; }
            else if (n < 1024) { if (k >= 64 && k < 128) v = F_a2[(k - 64) * 512 + (n - 512)]; }
            else { if (k >= 128) v = F_g2[(k - 128) * 512 + (n - 1024)]; }
            Wl[e] = f2bf(v); }
        for (size_t e = gt; e < 1024; e += NGT) lb[e] = sigmoidf_(F_lb_logits[1024 + e] - F_lb_logits[e]);
    }
}

__device__ __forceinline__ void norm_mod_phase(const Ctx& F, const float* xin, const float* gain, const float* shift, const float* scale) {
    const int ln = lane_id_();
    bf16_t* hb = (bf16_t*)(F.ws + WS_HB);
    const int gw = F.bid * NWAVES + F.wid, NGW = F.G * NWAVES;
    for (int ch = gw; ch < T / 32; ch += NGW) {
        const int row0 = ch * 32, b = row0 / S;
        f32x4 ga[4], sh[4];
#pragma unroll
        for (int j = 0; j < 4; ++j) { const int c = 4 * ln + 256 * j; const f32x4 g = *(const f32x4*)(gain + c), sc = *(const f32x4*)(scale + (size_t)b * 6144 + c);
            ga[j] = g * (sc + 1.0f); sh[j] = *(const f32x4*)(shift + (size_t)b * 6144 + c); }
        for (int r = 0; r < 32; r += 4) {
            f32x4 v[4][4]; float s[4];
#pragma unroll
            for (int u = 0; u < 4; ++u) { const float* xr = xin + (size_t)(row0 + r + u) * D; s[u] = 0.f;
#pragma unroll
                for (int j = 0; j < 4; ++j) v[u][j] = *(const f32x4*)(xr + 4 * ln + 256 * j); }
#pragma unroll
            for (int u = 0; u < 4; ++u) {
#pragma unroll
                for (int j = 0; j < 4; ++j) s[u] += (v[u][j][0] * v[u][j][0] + v[u][j][1] * v[u][j][1]) + (v[u][j][2] * v[u][j][2] + v[u][j][3] * v[u][j][3]);
                s[u] = wave_sum_fast(s[u]); }
#pragma unroll
            for (int u = 0; u < 4; ++u) { const float rstd = 1.0f / sqrtf(s[u] * (1.0f / D) + 1e-6f);
#pragma unroll
                for (int j = 0; j < 4; ++j) { const f32x4 o = v[u][j] * rstd * ga[j] + sh[j]; u32x2 w; w.x = pk2(o[0], o[1]); w.y = pk2(o[2], o[3]);
                    *(u32x2*)(hb + (size_t)(row0 + r + u) * D + 4 * ln + 256 * j) = w; } }
        }
    }
}

__device__ __forceinline__ void unpack8(const u32x4 r, float (&f)[8]) {
    f[0] = __uint_as_float(r.x << 16); f[1] = __uint_as_float(r.x & 0xffff0000u); f[2] = __uint_as_float(r.y << 16); f[3] = __uint_as_float(r.y & 0xffff0000u);
    f[4] = __uint_as_float(r.z << 16); f[5] = __uint_as_float(r.z & 0xffff0000u); f[6] = __uint_as_float(r.w << 16); f[7] = __uint_as_float(r.w & 0xffff0000u); }
__device__ __forceinline__ void norm_mod_bf16_phase(const Ctx& F, const bf16_t* xin, const float* gain, const float* shift, const float* scale) {
    const int ln = lane_id_();
    bf16_t* hb = (bf16_t*)(F.ws + WS_HB);
    const int gw = F.bid * NWAVES + F.wid, NGW = F.G * NWAVES;
    for (int ch = gw; ch < T / 32; ch += NGW) {
        const int row0 = ch * 32, b = row0 / S;
        float ga[2][8], sh[2][8];
#pragma unroll
        for (int j = 0; j < 2; ++j)
#pragma unroll
            for (int h = 0; h < 2; ++h) { const int c = 8 * ln + 512 * j + 4 * h; const f32x4 g = *(const f32x4*)(gain + c), sc = *(const f32x4*)(scale + (size_t)b * 6144 + c), s4 = *(const f32x4*)(shift + (size_t)b * 6144 + c);
#pragma unroll
                for (int e = 0; e < 4; ++e) { ga[j][4 * h + e] = g[e] * (sc[e] + 1.0f); sh[j][4 * h + e] = s4[e]; } }
        for (int r = 0; r < 32; r += 4) {
            u32x4 raw[4][2]; float s[4];
#pragma unroll
            for (int u = 0; u < 4; ++u)
#pragma unroll
                for (int j = 0; j < 2; ++j) raw[u][j] = *(const u32x4*)(xin + (size_t)(row0 + r + u) * D + 8 * ln + 512 * j);
#pragma unroll
            for (int u = 0; u < 4; ++u) { s[u] = 0.f;
#pragma unroll
                for (int j = 0; j < 2; ++j) { float f[8]; unpack8(raw[u][j], f);
#pragma unroll
                    for (int e = 0; e < 8; ++e) s[u] += f[e] * f[e]; }
                s[u] = wave_sum_fast(s[u]); }
#pragma unroll
            for (int u = 0; u < 4; ++u) { const float rstd = 1.0f / sqrtf(s[u] * (1.0f / D) + 1e-6f);
#pragma unroll
                for (int j = 0; j < 2; ++j) { float f[8]; unpack8(raw[u][j], f); float o[8];
#pragma unroll
                    for (int e = 0; e < 8; ++e) o[e] = f[e] * rstd * ga[j][e] + sh[j][e];
                    u32x4 w; w.x = pk2(o[0], o[1]); w.y = pk2(o[2], o[3]); w.z = pk2(o[4], o[5]); w.w = pk2(o[6], o[7]);
                    *(u32x4*)(hb + (size_t)(row0 + r + u) * D + 8 * ln + 512 * j) = w; } }
        }
    }
}

__device__ __forceinline__ void prep_even_phase(const Ctx& F) {
    const bf16_t* proj = (const bf16_t*)(F.ws + WS_BIG);
    float* stats = (float*)(F.ws + WS_STATS); float* cs = (float*)(F.ws + WS_CS);
    bf16_t* KR = (bf16_t*)(F.ws + WS_KR); bf16_t* AP = (bf16_t*)(F.ws + WS_AP);
    const int gw = F.bid * NWAVES + F.wid, NGW = F.G * NWAVES, lane = lane_id_();
    const int l32 = lane & 31;
    float mu8[8];
    { const f32x4 m0 = *(const f32x4*)(F_mu + 1536 + 8 * l32), m1 = *(const f32x4*)(F_mu + 1536 + 8 * l32 + 4); mu8[0] = m0[0]; mu8[1] = m0[1]; mu8[2] = m0[2]; mu8[3] = m0[3]; mu8[4] = m1[0]; mu8[5] = m1[1]; mu8[6] = m1[2]; mu8[7] = m1[3]; }
    const float inv = __builtin_amdgcn_exp2f(-13.287712379549449f * ((float)(lane & 15) * (1.0f / 16.0f)));
    const u32x4 z4 = {0u, 0u, 0u, 0u};
    for (int ch = gw; ch < T / 4; ch += NGW) {
        u32x4 rq[4], rkv[4], rc[4], rpv[4]; bf16_t kr[4][2]; int ps[4];
#pragma unroll
        for (int u = 0; u < 4; ++u) {
            const int row = 4 * ch + u, s = row % S;
            const bf16_t* p = proj + (size_t)row * IN_EVEN_P;
            rq[u] = lane < 48 ? *(const u32x4*)(p + 8 * lane) : z4;
            rkv[u] = *(const u32x4*)(p + 384 + 8 * l32);
            rc[u] = *(const u32x4*)(p + RW_OFF + 1536 + 8 * l32);
            rpv[u] = s > 0 ? *(const u32x4*)(p + RW_OFF + 1536 + 8 * l32 - IN_EVEN_P) : z4;
            kr[u][0] = p[640 + (lane & 15)]; kr[u][1] = p[656 + (lane & 15)];
            ps[u] = F_pos[row];
        }
#pragma unroll
        for (int u = 0; u < 4; ++u) {
            const int row = 4 * ch + u, b = row / S, s = row % S;
            float f[8]; float sq = 0.f, skv = 0.f;
            unpack8(rq[u], f);
#pragma unroll
            for (int e = 0; e < 8; ++e) sq += f[e] * f[e];
            unpack8(rkv[u], f);
#pragma unroll
            for (int e = 0; e < 8; ++e) skv += f[e] * f[e];
            sq = wave_sum_fast(sq); skv = wave_sum_fast(skv) * 0.5f;
            if (lane == 0) { stats[2 * row] = 1.0f / sqrtf(sq * (1.0f / 384.f) + 1e-6f); stats[2 * row + 1] = 1.0f / sqrtf(skv * (1.0f / 256.f) + 1e-6f); }
            if (lane < 16) {
                const float ang = (float)ps[u] * inv;
                double rev = (double)ang * 0.15915494309189535; rev -= floor(rev);
                const float cv = __builtin_amdgcn_cosf((float)rev), sv = __builtin_amdgcn_sinf((float)rev);
                cs[(size_t)row * 32 + lane] = cv; cs[(size_t)row * 32 + 16 + lane] = sv;
                const float x1 = bf2f(kr[u][0]), x2 = bf2f(kr[u][1]);
                const bf16_t o1 = f2bf(x1 * cv - x2 * sv), o2 = f2bf(x1 * sv + x2 * cv);
                { bf16_t* kp = KR + (size_t)row * 32; kp[lane] = o1; kp[16 + lane] = o2; }
            }
            if (lane < 32) {
                float cu[8], pv[8], o[8]; unpack8(rc[u], cu); unpack8(rpv[u], pv);
#pragma unroll
                for (int e = 0; e < 8; ++e) { float v = cu[e] + (pv[e] - cu[e]) * mu8[e]; if (lane < 8) v = tanhf(v); else if (lane >= 16) v = sigmoidf_(v); o[e] = v; }
                *(u32x4*)(AP + (size_t)row * 256 + 8 * lane) = (u32x4){pk2(o[0], o[1]), pk2(o[2], o[3]), pk2(o[4], o[5]), pk2(o[6], o[7])};
            }
        }
    }
}

__device__ __forceinline__ int crow(int r, int hi) { return (r & 3) + 8 * (r >> 2) + 4 * hi; }
constexpr int KP = 208, VP = 136;
__device__ __forceinline__ void attn_bh(const Ctx& F, int b, int h) {
    const bf16_t* Q = (const bf16_t*)(F.ws + WS_Q);
    const bf16_t* Kh = (const bf16_t*)(F.ws + WS_KH) + (size_t)(b * 8 + h) * S * 64;
    const bf16_t* Krp = (const bf16_t*)(F.ws + WS_KR) + (size_t)b * S * 32;
    const bf16_t* Vh = (const bf16_t*)(F.ws + WS_VH) + (size_t)(b * 8 + h) * S * 64;
    bf16_t* Y = (bf16_t*)(F.ws + WS_HB);
    LAS unsigned char* Kl = F.lds; LAS unsigned char* Vl = F.lds + 64 * KP;
    const int tid = (F.wid * 64 + lane_id_()), lane = lane_id_(), w = F.wid, q31 = lane & 31, hi = lane >> 5;
    for (int qb = 0; qb < 8; ++qb) {
        const int q0 = qb * 256, NT = 4 * (qb + 1), qrow = q0 + 32 * w + q31, wlast = q0 + 32 * w + 31;
        bf16x8 qf[6];
#pragma unroll
        for (int d0 = 0; d0 < 6; ++d0) qf[d0] = *(const bf16x8*)(Q + (size_t)(b * S + qrow) * 768 + h * 96 + 16 * d0 + 8 * hi);
        f32x16 o0, o1;
#pragma unroll
        for (int r = 0; r < 16; ++r) { o0[r] = 0.f; o1[r] = 0.f; }
        float mrun = -INFINITY, lrun = 0.f;
        u32x4 kr0, kr1, vr;
        kr0 = *(const u32x4*)(Kh + (size_t)tid * 8); kr1 = (u32x4){0u, 0u, 0u, 0u}; if (tid < 256) kr1 = *(const u32x4*)(Krp + (size_t)tid * 8); vr = *(const u32x4*)(Vh + (size_t)tid * 8);
        for (int t = 0; t < NT; ++t) {
            __syncthreads();
            *(LAS u32x4*)(Kl + (tid >> 3) * KP + (tid & 7) * 16) = kr0;
            if (tid < 256) *(LAS u32x4*)(Kl + (tid >> 2) * KP + 128 + (tid & 3) * 16) = kr1;
            { const int kv = tid >> 3, dc = tid & 7;
#pragma unroll
              for (int j = 0; j < 4; ++j) { const unsigned wv = vr[j];
                  *(LAS bf16_t*)(Vl + (8 * dc + 2 * j) * VP + kv * 2) = (bf16_t)(wv & 0xffffu); *(LAS bf16_t*)(Vl + (8 * dc + 2 * j + 1) * VP + kv * 2) = (bf16_t)(wv >> 16); } }
            __syncthreads();
            if (t + 1 < NT) { const bf16_t* kn = Kh + (size_t)(t + 1) * 64 * 64; const bf16_t* krn = Krp + (size_t)(t + 1) * 64 * 32; const bf16_t* vn = Vh + (size_t)(t + 1) * 64 * 64;
                kr0 = *(const u32x4*)(kn + (size_t)tid * 8); if (tid < 256) kr1 = *(const u32x4*)(krn + (size_t)tid * 8); vr = *(const u32x4*)(vn + (size_t)tid * 8); }
            const int kv0 = 64 * t;
            if (kv0 <= wlast) {
                f32x16 p0, p1;
#pragma unroll
                for (int r = 0; r < 16; ++r) { p0[r] = 0.f; p1[r] = 0.f; }
#pragma unroll
                for (int d0 = 0; d0 < 6; ++d0) {
                    const bf16x8 a0 = *(const LAS bf16x8*)(Kl + q31 * KP + (16 * d0 + 8 * hi) * 2);
                    const bf16x8 a1 = *(const LAS bf16x8*)(Kl + (32 + q31) * KP + (16 * d0 + 8 * hi) * 2);
                    p0 = __builtin_amdgcn_mfma_f32_32x32x16_bf16(a0, qf[d0], p0, 0, 0, 0);
                    p1 = __builtin_amdgcn_mfma_f32_32x32x16_bf16(a1, qf[d0], p1, 0, 0, 0);
                }
                if (kv0 + 63 > q0 + 32 * w) {
#pragma unroll
                    for (int r = 0; r < 16; ++r) { const int kv = kv0 + crow(r, hi); if (kv > qrow) p0[r] = -INFINITY; if (kv + 32 > qrow) p1[r] = -INFINITY; }
                }
                float mt = p0[0];
#pragma unroll
                for (int r = 1; r < 16; ++r) mt = fmaxf(mt, p0[r]);
#pragma unroll
                for (int r = 0; r < 16; ++r) mt = fmaxf(mt, p1[r]);
                mt = fmaxf(mt, __shfl_xor(mt, 32));
                if (__any(mt > mrun + 8.0f)) {
                    const float mnew = fmaxf(mrun, mt), alpha = __builtin_amdgcn_exp2f(mrun - mnew);
                    mrun = mnew; lrun *= alpha;
#pragma unroll
                    for (int r = 0; r < 16; ++r) { o0[r] *= alpha; o1[r] *= alpha; }
                }
                float ls = 0.f;
#pragma unroll
                for (int r = 0; r < 16; ++r) { p0[r] = __builtin_amdgcn_exp2f(p0[r] - mrun); p1[r] = __builtin_amdgcn_exp2f(p1[r] - mrun); ls += p0[r] + p1[r]; }
                lrun += ls;
                bf16x8 pk[4];
#pragma unroll
                for (int c2 = 0; c2 < 2; ++c2) {
                    u32x4 a, bq;
#pragma unroll
                    for (int j = 0; j < 4; ++j) { a[j] = pk2(p0[8 * c2 + 2 * j], p0[8 * c2 + 2 * j + 1]); bq[j] = pk2(p1[8 * c2 + 2 * j], p1[8 * c2 + 2 * j + 1]); }
                    pk[c2] = __builtin_bit_cast(bf16x8, a); pk[2 + c2] = __builtin_bit_cast(bf16x8, bq);
                }
#pragma unroll
                for (int hc = 0; hc < 4; ++hc) {
                    const int kvb = 16 * hc + 4 * hi;
                    const u32x2 l0 = *(const LAS u32x2*)(Vl + q31 * VP + kvb * 2), h0 = *(const LAS u32x2*)(Vl + q31 * VP + (kvb + 8) * 2);
                    const u32x2 l1 = *(const LAS u32x2*)(Vl + (32 + q31) * VP + kvb * 2), h1 = *(const LAS u32x2*)(Vl + (32 + q31) * VP + (kvb + 8) * 2);
                    const u32x4 va = {l0.x, l0.y, h0.x, h0.y}, vb = {l1.x, l1.y, h1.x, h1.y};
                    o0 = __builtin_amdgcn_mfma_f32_32x32x16_bf16(__builtin_bit_cast(bf16x8, va), pk[hc], o0, 0, 0, 0);
                    o1 = __builtin_amdgcn_mfma_f32_32x32x16_bf16(__builtin_bit_cast(bf16x8, vb), pk[hc], o1, 0, 0, 0);
                }
            }
        }
        lrun += __shfl_xor(lrun, 32);
        const float inv = 1.0f / lrun;
        bf16_t* yp = Y + (size_t)(b * S + qrow) * D + h * 64;
#pragma unroll
        for (int g = 0; g < 4; ++g) {
            u32x2 w0, w1; w0.x = pk2(o0[4 * g] * inv, o0[4 * g + 1] * inv); w0.y = pk2(o0[4 * g + 2] * inv, o0[4 * g + 3] * inv);
            w1.x = pk2(o1[4 * g] * inv, o1[4 * g + 1] * inv); w1.y = pk2(o1[4 * g + 2] * inv, o1[4 * g + 3] * inv);
            *(u32x2*)(yp + 8 * g + 4 * hi) = w0; *(u32x2*)(yp + 32 + 8 * g + 4 * hi) = w1;
        }
    }
    __syncthreads();
}

constexpr int RC = 32;
__device__ __forceinline__ void rwkv_bh(const Ctx& F, int b, int h) {
    const bf16_t* proj = (const bf16_t*)(F.ws + WS_BIG); const bf16_t* LO = (const bf16_t*)(F.ws + WS_LORA);
    bf16_t* Y = (bf16_t*)(F.ws + WS_HB);
    LAS float* Wl = (LAS float*)F.lds; LAS float* KKl = Wl + RC * 64; LAS float* KAl = KKl + RC * 64; LAS float* Kl = KAl + RC * 64; LAS float* WRl = Kl + RC * 64; LAS float* Vl = WRl + RC * 64; LAS float* Yl = Vl + RC * 64;
    LAS float* C1l = Yl + RC * 128; LAS float* C2l = C1l + RC; LAS float* BOl = C2l + RC;
    const int lane = lane_id_(), w = F.wid, col = h * 64 + lane;
    const float mu_r = F_mu[col], mu_k = F_mu[512 + col], mu_v = F_mu[1024 + col], w0 = F_w0[col], a0 = F_a0[col], k_k = F_k_k[col], k_a = F_k_a[col], r_k = F_r_k[col], ln_w = F_ln_w[col], ln_b = F_ln_b[col];
    const int rp = lane >> 4, kq = lane & 15;
    const bool b0 = (kq & 1) != 0, b1 = (kq & 2) != 0;
    f32x2 sA[2] = {(f32x2){0.f, 0.f}, (f32x2){0.f, 0.f}}, sB[2] = {(f32x2){0.f, 0.f}, (f32x2){0.f, 0.f}};
    bf16_t raw[RC / 8][8];
#define RW_LOAD(CH) do { _Pragma("unroll") for (int i = 0; i < RC / 8; ++i) { const int t_ = (CH) * RC + w + 8 * i; const size_t row_ = (size_t)b * S + t_; \
        const bf16_t* p_ = proj + row_ * IN_EVEN_P + RW_OFF + col; raw[i][0] = p_[0]; raw[i][1] = p_[512]; raw[i][2] = p_[1024]; \
        if (t_ > 0) { raw[i][3] = p_[-IN_EVEN_P]; raw[i][4] = p_[512 - IN_EVEN_P]; raw[i][5] = p_[1024 - IN_EVEN_P]; } else { raw[i][3] = 0; raw[i][4] = 0; raw[i][5] = 0; } \
        raw[i][6] = LO[row_ * 1536 + col]; raw[i][7] = LO[row_ * 1536 + 512 + col]; } } while (0)
    RW_LOAD(0);
    for (int ch = 0; ch < S / RC; ++ch) {
        const int t0 = ch * RC;
#pragma unroll
        for (int i = 0; i < RC / 8; ++i) {
            const int tl = w + 8 * i;
            float r = bf2f(raw[i][0]), k = bf2f(raw[i][1]), v = bf2f(raw[i][2]);
            r += (bf2f(raw[i][3]) - r) * mu_r; k += (bf2f(raw[i][4]) - k) * mu_k; v += (bf2f(raw[i][5]) - v) * mu_v;
            const float dec = __expf(-0.6065306597126334f * sigmoidf_(w0 + bf2f(raw[i][6])));
            const float a = sigmoidf_(a0 + bf2f(raw[i][7]));
            float kk = k * k_k;
            const float km = k * (1.0f + (a - 1.0f) * k_a);
            const float s_n = wave_sum_fast(kk * kk), s_b = wave_sum_fast(r * km * r_k), s_2 = wave_sum_fast(km * r);
            kk = kk / fmaxf(sqrtf(s_n), 1e-12f);
            const float ka = kk * a;
            const float s_1 = wave_sum_fast(ka * r);
            Wl[tl * 64 + lane] = dec; KKl[tl * 64 + lane] = kk; KAl[tl * 64 + lane] = ka; Kl[tl * 64 + lane] = km; WRl[tl * 64 + lane] = dec * r; Vl[tl * 64 + lane] = v;
            if (lane == 0) { C1l[tl] = s_1; C2l[tl] = s_2; BOl[tl] = s_b; }
        }
        if (ch + 1 < S / RC) RW_LOAD(ch + 1);
        bf16_t gq[RC / 8];
#pragma unroll
        for (int i = 0; i < RC / 8; ++i) gq[i] = LO[((size_t)b * S + t0 + w + 8 * i) * 1536 + 1024 + col];
        __syncthreads();
        {
            f32x4 w4 = *(const LAS f32x4*)(Wl + 4 * kq), kk4 = *(const LAS f32x4*)(KKl + 4 * kq), ka4 = *(const LAS f32x4*)(KAl + 4 * kq), k4 = *(const LAS f32x4*)(Kl + 4 * kq), wr4 = *(const LAS f32x4*)(WRl + 4 * kq);
            f32x2 v2 = *(const LAS f32x2*)(Vl + 8 * w + 2 * rp);
#pragma unroll 2
            for (int tl = 0; tl < RC; ++tl) {
                const int tn = (tl + 1 < RC) ? tl + 1 : tl;
                const f32x4 w4n = *(const LAS f32x4*)(Wl + tn * 64 + 4 * kq), kk4n = *(const LAS f32x4*)(KKl + tn * 64 + 4 * kq), ka4n = *(const LAS f32x4*)(KAl + tn * 64 + 4 * kq),
                            k4n = *(const LAS f32x4*)(Kl + tn * 64 + 4 * kq), wr4n = *(const LAS f32x4*)(WRl + tn * 64 + 4 * kq);
                const f32x2 v2n = *(const LAS f32x2*)(Vl + tn * 64 + 8 * w + 2 * rp);
                const f32x2 kkA = {kk4[0], kk4[1]}, kkB = {kk4[2], kk4[3]}, wrA = {wr4[0], wr4[1]}, wrB = {wr4[2], wr4[3]};
                const f32x2 d0 = sA[0] * kkA + sB[0] * kkB, d1 = sA[1] * kkA + sB[1] * kkB, d2 = sA[0] * wrA + sB[0] * wrB, d3 = sA[1] * wrA + sB[1] * wrB;
                const float V0 = d0[0] + d0[1], V1 = d1[0] + d1[1], V2 = d2[0] + d2[1], V3 = d3[0] + d3[1];
                const float A = (b0 ? V1 : V0) + dpp_f<0xB1>(b0 ? V0 : V1);
                const float Bq = (b0 ? V3 : V2) + dpp_f<0xB1>(b0 ? V2 : V3);
                float Cc = (b1 ? Bq : A) + dpp_f<0x4E>(b1 ? A : Bq);
                Cc += dpp_f<0x124>(Cc);
                Cc += dpp_f<0x128>(Cc);
                const float sa0 = -dpp_f<0x00>(Cc), sa1 = -dpp_f<0x55>(Cc);
                { const f32x2 wA = {w4[0], w4[1]}, wB = {w4[2], w4[3]}, kaA = {ka4[0], ka4[1]}, kaB = {ka4[2], ka4[3]}, kA = {k4[0], k4[1]}, kB = {k4[2], k4[3]};
                  sA[0] = sA[0] * wA + kaA * sa0 + kA * v2[0]; sB[0] = sB[0] * wB + kaB * sa0 + kB * v2[0];
                  sA[1] = sA[1] * wA + kaA * sa1 + kA * v2[1]; sB[1] = sB[1] * wB + kaB * sa1 + kB * v2[1]; }
                Yl[tl * 128 + (4 * w + rp) * 4 + (kq & 3)] = Cc;
                w4 = w4n; kk4 = kk4n; ka4 = ka4n; k4 = k4n; wr4 = wr4n; v2 = v2n;
            }
        }
        __syncthreads();
#pragma unroll
        for (int i = 0; i < RC / 8; ++i) {
            const int tl = w + 8 * i, t = t0 + tl; const size_t row = (size_t)b * S + t;
            const float y = Yl[tl * 128 + (lane >> 1) * 4 + 2 + (lane & 1)] - Yl[tl * 128 + (lane >> 1) * 4 + (lane & 1)] * C1l[tl] + Vl[tl * 64 + lane] * C2l[tl];
            const float s1 = wave_sum_fast(y), s2 = wave_sum_fast(y * y);
            const float mean = s1 * (1.0f / 64.f), var = fmaxf(s2 * (1.0f / 64.f) - mean * mean, 0.f);
            const float yn = (y - mean) * (1.0f / sqrtf(var + 64e-5f)) * ln_w + ln_b;
            const float bonus = BOl[tl] * Vl[tl * 64 + lane];
            Y[row * D + 512 + col] = f2bf((yn + bonus) * bf2f(gq[i]));
        }
        __syncthreads();
    }
#undef RW_LOAD
}


constexpr int RX_QT = 0, RX_WYT = 4096, RX_NGT = 6144, RX_HT = 14336, RX_VT = 18432, RX_CC = 22528, RX_BON = 22784, RX_BYTES = 23040;
constexpr int RG = 4;
constexpr int RA_ZLO = 0, RA_DT = 4608, RA_ZHI = 9728, RA_ELO = 14336, RA_EHI = 18944, RA_AT = 23552, RA_M2 = 28672, RA_N1T = 31232, RA_CC = 33792, RA_BYTES = 34048;
constexpr int RB_SB = 0, RB_YL = 9216;
__device__ __forceinline__ unsigned launder_(unsigned x) { asm volatile("" : "+v"(x)); return x; }
__device__ __forceinline__ bf16x8 lds16(const LAS unsigned char* p) { return *(const LAS bf16x8*)p; }
__device__ __forceinline__ bf16x8 glb16(const unsigned char* p) { return *(const bf16x8*)p; }
#define MFMA16(a, b, c) __builtin_amdgcn_mfma_f32_16x16x32_bf16((a), (b), (c), 0, 0, 0)

__device__ __forceinline__ void rwkv_phaseA(const Ctx& F, LAS unsigned char* W, unsigned char* X, int b, int h, int c) {
    const bf16_t* proj = (const bf16_t*)(F.ws + WS_BIG); const bf16_t* LO = (const bf16_t*)(F.ws + WS_LORA);
    const int lane = lane_id_(), i = lane & 15, g = lane >> 4, col = h * 64 + lane;
    const float mu_r = F_mu[col], mu_k = F_mu[512 + col], mu_v = F_mu[1024 + col], w0 = F_w0[col], a0 = F_a0[col], k_k = F_k_k[col], k_a = F_k_a[col], r_k = F_r_k[col];
    float Bc = 0.f, cprev = 1.f;
    {
        const unsigned ul0 = (unsigned)lane;
        const size_t row0 = (size_t)b * S + c * 32;
        const bf16_t* pb = proj + row0 * IN_EVEN_P + RW_OFF + h * 64; const bf16_t* lb = LO + row0 * 1536 + h * 64;
        float pr_ = 0.f, pk_ = 0.f, pv_ = 0.f;
        if (c > 0) { const bf16_t* pp = pb - IN_EVEN_P; pr_ = bf2f(pp[ul0]); pk_ = bf2f(pp[512 + ul0]); pv_ = bf2f(pp[1024 + ul0]); }
        bf16_t cur[8][5], nxt[8][5];
#define RW_LD8(dst, t8_) do { const unsigned ul = launder_(ul0); _Pragma("unroll") for (int tt = 0; tt < 8; ++tt) { const bf16_t* p = pb + (size_t)(8 * (t8_) + tt) * IN_EVEN_P; const bf16_t* lo = lb + (size_t)(8 * (t8_) + tt) * 1536; \
            dst[tt][0] = p[ul]; dst[tt][1] = p[512 + ul]; dst[tt][2] = p[1024 + ul]; dst[tt][3] = lo[ul]; dst[tt][4] = lo[512 + ul]; } } while (0)
        RW_LD8(cur, 0);
#pragma unroll 1
        for (int t8 = 0; t8 < 4; ++t8) {
            const unsigned ulane = launder_(ul0);
            { const int tn = t8 < 3 ? t8 + 1 : 3; RW_LD8(nxt, tn); }
            unsigned at8[4], dt8[4], vt8[4];
#pragma unroll
            for (int tt = 0; tt < 8; ++tt) {
                const int t = 8 * t8 + tt;
                const float r0 = bf2f(cur[tt][0]), k0 = bf2f(cur[tt][1]), v0 = bf2f(cur[tt][2]);
                const float r = r0 + (pr_ - r0) * mu_r, k = k0 + (pk_ - k0) * mu_k, v = v0 + (pv_ - v0) * mu_v; pr_ = r0; pk_ = k0; pv_ = v0;
                Bc += -0.6065306597126334f * sigmoidf_(w0 + bf2f(cur[tt][3]));
                const float ct = __expf(Bc), ci = __expf(-Bc);
                const float a = sigmoidf_(a0 + bf2f(cur[tt][4]));
                float kk = k * k_k; const float km = k * (1.0f + (a - 1.0f) * k_a);
                const float s_n = wave_sum_fast(kk * kk), s_b = wave_sum_fast(r * km * r_k);
                kk = kk * __builtin_amdgcn_rsqf(fmaxf(s_n, 1e-24f));
                const float Ak = kk * a * ci, Kc = km * ci, Dk = kk * cprev, Rk = r * ct; cprev = ct;
                const bf16_t ab = f2bf(Ak), db = f2bf(Dk), vb = f2bf(v);
                *(LAS bf16_t*)(W + RA_ZLO + t * 144 + 2 * lane) = ab; *(LAS bf16_t*)(W + RA_ZHI + t * 144 + 2 * lane) = f2bf(Kc);
                *(LAS bf16_t*)(W + RA_ELO + t * 144 + 2 * lane) = db; *(LAS bf16_t*)(W + RA_EHI + t * 144 + 2 * lane) = f2bf(Rk);
                if (tt & 1) { at8[tt >> 1] |= (unsigned)ab << 16; dt8[tt >> 1] |= (unsigned)db << 16; vt8[tt >> 1] |= (unsigned)vb << 16; } else { at8[tt >> 1] = ab; dt8[tt >> 1] = db; vt8[tt >> 1] = vb; }
                if (lane == 0) *(float*)(X + RX_BON + 4 * t) = s_b;
            }
            *(LAS u32x4*)(W + RA_AT + lane * 80 + 16 * t8) = (u32x4){at8[0], at8[1], at8[2], at8[3]};
            *(LAS u32x4*)(W + RA_DT + lane * 80 + 16 * t8) = (u32x4){dt8[0], dt8[1], dt8[2], dt8[3]};
            *(u32x4*)(X + RX_VT + 16 * t8 + ulane * 64u) = (u32x4){vt8[0], vt8[1], vt8[2], vt8[3]};
#pragma unroll
            for (int tt = 0; tt < 8; ++tt)
#pragma unroll
                for (int q = 0; q < 5; ++q) cur[tt][q] = nxt[tt][q];
        }
#undef RW_LD8
    }
    *(LAS float*)(W + RA_CC + 4 * lane) = cprev; *(float*)(X + RX_CC + (unsigned)(4 * lane)) = cprev;
    asm volatile("s_waitcnt lgkmcnt(0)" ::: "memory");
    {
        bf16x8 bfr[2][4];
#pragma unroll
        for (int ks = 0; ks < 2; ++ks)
#pragma unroll
            for (int q = 0; q < 4; ++q) bfr[ks][q] = lds16(W + (q < 2 ? RA_ELO : RA_EHI) + (16 * (q & 1) + i) * 144 + (32 * ks + 8 * g) * 2);
#pragma unroll 1
        for (int mt = 0; mt < 4; ++mt) {
            const LAS unsigned char* arow = W + (mt < 2 ? RA_ZLO : RA_ZHI) + (16 * (mt & 1) + i) * 144 + 16 * g;
            const bf16x8 a0 = lds16(arow), a1 = lds16(arow + 64);
            f32x4 Tt[4];
#pragma unroll
            for (int nt = 0; nt < 4; ++nt) { Tt[nt] = MFMA16(a0, bfr[0][nt], ((f32x4){0.f, 0.f, 0.f, 0.f})); Tt[nt] = MFMA16(a1, bfr[1][nt], Tt[nt]); }
            const int s0 = 16 * (mt & 1) + 4 * g;
#pragma unroll
            for (int nt = 0; nt < 2; ++nt) {
                const int t = 16 * nt + i; f32x4 lo = Tt[nt], hi = Tt[2 + nt];
#pragma unroll
                for (int r = 0; r < 4; ++r) { if (!(s0 + r < t)) lo[r] = 0.f; if (!(s0 + r <= t)) hi[r] = 0.f; }
                if (mt < 2) {
#pragma unroll
                    for (int r = 0; r < 4; ++r) *(LAS float*)(W + RA_ZLO + ((s0 + r) * 32 + t) * 4) = lo[r];
                    *(LAS u32x2*)(W + RA_N1T + t * 80 + s0 * 2) = (u32x2){pk2(hi[0], hi[1]), pk2(hi[2], hi[3])};
                } else {
#pragma unroll
                    for (int r = 0; r < 4; ++r) { *(LAS bf16_t*)(W + RA_M2 + (s0 + r) * 80 + 2 * t) = f2bf(lo[r]);
                                                  *(LAS float*)(W + RA_ELO + ((s0 + r) * 32 + t) * 4) = hi[r]; }
                }
            }
        }
    }
    asm volatile("s_waitcnt lgkmcnt(0)" ::: "memory");
    {
        const int tc = lane & 31;
        float x[32];
        x[31] = (tc == 31) ? 1.f : 0.f;
#pragma unroll
        for (int s = 30; s >= 0; --s) {
            float acc = 0.f;
#pragma unroll
            for (int j4 = (s + 1) / 4; j4 < 8; ++j4) { const f32x4 mrow = *(const LAS f32x4*)(W + RA_ZLO + (s * 32 + 4 * j4) * 4);
#pragma unroll
                for (int e = 0; e < 4; ++e) if (4 * j4 + e > s) acc += mrow[e] * x[4 * j4 + e]; }
            x[s] = (s == tc) ? 1.f : ((s < tc) ? -acc : 0.f);
            asm volatile("" : "+v"(x[s]) :: "memory");
        }
        asm volatile("s_waitcnt lgkmcnt(0)" ::: "memory");
#pragma unroll
        for (int q = 0; q < 4; ++q) *(LAS u32x4*)(W + RA_ZLO + tc * 80 + 16 * q) = (u32x4){pk2(x[8 * q], x[8 * q + 1]), pk2(x[8 * q + 2], x[8 * q + 3]), pk2(x[8 * q + 4], x[8 * q + 5]), pk2(x[8 * q + 6], x[8 * q + 7])};
    }
    asm volatile("s_waitcnt lgkmcnt(0)" ::: "memory");
    {
        const bf16x8 tb0 = lds16(W + RA_ZLO + i * 80 + 16 * g), tb1 = lds16(W + RA_ZLO + (16 + i) * 80 + 16 * g);
#pragma unroll 1
        for (int mt = 0; mt < 6; ++mt) {
            const bf16x8 xa = lds16(W + (mt < 4 ? RA_DT + (16 * mt + i) * 80 : RA_M2 + (16 * (mt - 4) + i) * 80) + 16 * g);
            const f32x4 x0 = MFMA16(xa, tb0, ((f32x4){0.f, 0.f, 0.f, 0.f})), x1 = MFMA16(xa, tb1, ((f32x4){0.f, 0.f, 0.f, 0.f}));
#pragma unroll
            for (int r = 0; r < 4; ++r) { *(LAS bf16_t*)(W + RA_ZLO + (16 * mt + 4 * g + r) * 80 + i * 2) = f2bf(x0[r]); *(LAS bf16_t*)(W + RA_ZLO + (16 * mt + 4 * g + r) * 80 + (16 + i) * 2) = f2bf(x1[r]); }
        }
    }
    asm volatile("s_waitcnt lgkmcnt(0)" ::: "memory");
    {
        bf16x8 xa[6];
#pragma unroll
        for (int mt = 0; mt < 6; ++mt) xa[mt] = lds16(W + RA_ZLO + (16 * mt + i) * 80 + 16 * g);
#pragma unroll 1
        for (int nt = 0; nt < 6; ++nt) {
            const unsigned li = launder_((unsigned)i), lg8 = launder_((unsigned)(8 * g));
            const bf16x8 bb = lds16(W + (nt < 2 ? RA_N1T + (16 * nt + i) * 80 : RA_AT + (16 * (nt - 2) + i) * 80) + 16 * g);
            if (nt < 2) {
                const int t = 16 * nt + i;
#pragma unroll
                for (int mt = 0; mt < 6; ++mt) {
                    const f32x4 o = MFMA16(xa[mt], bb, ((f32x4){0.f, 0.f, 0.f, 0.f}));
                    if (mt < 4) { const u32x2 rk = *(const LAS u32x2*)(W + RA_EHI + t * 144 + (16 * mt + 4 * g) * 2);
                        const float q0 = __uint_as_float(rk.x << 16) - o[0], q1 = __uint_as_float(rk.x & 0xffff0000u) - o[1], q2 = __uint_as_float(rk.y << 16) - o[2], q3 = __uint_as_float(rk.y & 0xffff0000u) - o[3];
                        *(u32x2*)(X + RX_QT + 32 * mt + nt * 2048 + (li * 128u + lg8)) = (u32x2){pk2(q0, q1), pk2(q2, q3)}; }
                    else { float n2[4];
#pragma unroll
                        for (int r = 0; r < 4; ++r) n2[r] = *(const LAS float*)(W + RA_ELO + ((16 * (mt - 4) + 4 * g + r) * 32 + t) * 4);
                        *(u32x2*)(X + RX_WYT + 32 * (mt - 4) + nt * 1024 + (li * 64u + lg8)) = (u32x2){pk2(n2[0] - o[0], n2[1] - o[1]), pk2(n2[2] - o[2], n2[3] - o[3])}; }
                }
            } else {
                const int kp = 16 * (nt - 2) + i; const float ccn = *(const LAS float*)(W + RA_CC + 4 * kp);
#pragma unroll
                for (int mt = 0; mt < 6; ++mt) {
                    const f32x4 o = MFMA16(xa[mt], bb, ((f32x4){0.f, 0.f, 0.f, 0.f}));
                    if (mt < 4) *(u32x2*)(X + RX_NGT + 32 * mt + (nt - 2) * 2048 + (li * 128u + lg8)) = (u32x2){pk2(-o[0] * ccn, -o[1] * ccn), pk2(-o[2] * ccn, -o[3] * ccn)};
                    else { float kc[4];
#pragma unroll
                        for (int r = 0; r < 4; ++r) kc[r] = bf2f(*(const LAS bf16_t*)(W + RA_ZHI + (16 * (mt - 4) + 4 * g + r) * 144 + 2 * kp));
                        *(u32x2*)(X + RX_HT + 32 * (mt - 4) + (nt - 2) * 1024 + (li * 64u + lg8)) = (u32x2){pk2((kc[0] - o[0]) * ccn, (kc[1] - o[1]) * ccn), pk2((kc[2] - o[2]) * ccn, (kc[3] - o[3]) * ccn)}; }
                }
            }
        }
    }
}

__device__ __forceinline__ void rwkv_chunked_bh(const Ctx& F, int b, int h) {
    const bf16_t* proj = (const bf16_t*)(F.ws + WS_BIG); const bf16_t* LO = (const bf16_t*)(F.ws + WS_LORA);
    bf16_t* Y = (bf16_t*)(F.ws + WS_HB);
    unsigned char* XS = F.ws + WS_AP + (size_t)F.bid * (RG * RX_BYTES);
    LAS unsigned char* L = F.lds;
    const int lane = lane_id_(), w = F.wid, i = lane & 15, g = lane >> 4, col = h * 64 + lane;
    const int vt = w >> 1, kh = w & 1;
    const float mu_v = F_mu[1024 + col], ln_w = F_ln_w[col], ln_b = F_ln_b[col];
    f32x4 sT[2] = {(f32x4){0.f, 0.f, 0.f, 0.f}, (f32x4){0.f, 0.f, 0.f, 0.f}};
#pragma unroll 1
    for (int grp = 0; grp < S / 32 / RG; ++grp) {
        __syncthreads();
        if (w < RG) rwkv_phaseA(F, L + w * RA_BYTES, XS + w * RX_BYTES, b, h, grp * RG + w);
        asm volatile("s_waitcnt vmcnt(0) lgkmcnt(0)" ::: "memory");
        __syncthreads();
#pragma unroll 1
        for (int cc = 0; cc < RG; ++cc) {
            const int c = grp * RG + cc; const unsigned char* X = XS + cc * RX_BYTES;
            bf16x8 ng[2][2], hf[2], qf[2], wyf, vf; f32x4 c4[2];
            const unsigned o128 = launder_((unsigned)(i * 128 + 16 * g)), o64 = launder_((unsigned)(i * 64 + 16 * g)), ulane = launder_((unsigned)lane);
#pragma unroll
            for (int q = 0; q < 2; ++q) { const int kt = 2 * kh + q;
                ng[q][0] = glb16(X + RX_NGT + 16 * kt * 128 + o128); ng[q][1] = glb16(X + RX_NGT + 16 * kt * 128 + 64 + o128);
                hf[q] = glb16(X + RX_HT + 16 * kt * 64 + o64); c4[q] = *(const f32x4*)(X + RX_CC + 16 * kt * 4 + (unsigned)(16 * g)); }
            qf[0] = glb16(X + RX_QT + 16 * kh * 128 + o128); qf[1] = glb16(X + RX_QT + 16 * kh * 128 + 64 + o128);
            wyf = glb16(X + RX_WYT + 16 * kh * 64 + o64); vf = glb16(X + RX_VT + 16 * vt * 64 + o64);
            bf16_t pv0[4], pv1[4], gq[4]; float bon[4];
#pragma unroll
            for (int j = 0; j < 4; ++j) { const int t = c * 32 + w + 8 * j; const size_t row = (size_t)b * S + t; const bf16_t* p = proj + row * IN_EVEN_P + RW_OFF + 1024 + h * 64; const unsigned ul = ulane;
                pv0[j] = p[ul]; pv1[j] = t > 0 ? (p - IN_EVEN_P)[ul] : (bf16_t)0; gq[j] = (LO + row * 1536 + 1024 + h * 64)[ul]; bon[j] = *(const float*)(X + RX_BON + 4 * (w + 8 * j)); }
#pragma unroll
            for (int q = 0; q < 2; ++q) *(LAS u32x2*)(L + RB_SB + (16 * vt + i) * 144 + (16 * (2 * kh + q) + 4 * g) * 2) = (u32x2){pk2(sT[q][0], sT[q][1]), pk2(sT[q][2], sT[q][3])};
            __syncthreads();
            const bf16x8 bs0 = lds16(L + RB_SB + (16 * vt + i) * 144 + (8 * g) * 2), bs1 = lds16(L + RB_SB + (16 * vt + i) * 144 + (32 + 8 * g) * 2);
            f32x4 y = MFMA16(qf[0], bs0, ((f32x4){0.f, 0.f, 0.f, 0.f})); y = MFMA16(qf[1], bs1, y); y = MFMA16(wyf, vf, y);
#pragma unroll
            for (int q = 0; q < 2; ++q) { f32x4 a = sT[q] * c4[q]; a = MFMA16(ng[q][0], bs0, a); a = MFMA16(ng[q][1], bs1, a); sT[q] = MFMA16(hf[q], vf, a); }
#pragma unroll
            for (int r = 0; r < 4; ++r) *(LAS float*)(L + RB_YL + ((16 * kh + 4 * g + r) * 64 + 16 * vt + i) * 4) = y[r];
            __syncthreads();
#pragma unroll
            for (int j = 0; j < 4; ++j) {
                const int tl = w + 8 * j; const size_t row = (size_t)b * S + c * 32 + tl;
                const float yv = *(const LAS float*)(L + RB_YL + (tl * 64 + lane) * 4);
                const float s1 = wave_sum_fast(yv), s2 = wave_sum_fast(yv * yv);
                const float mean = s1 * (1.0f / 64.f), var = fmaxf(s2 * (1.0f / 64.f) - mean * mean, 0.f);
                const float yn = (yv - mean) * (1.0f / sqrtf(var + 64e-5f)) * ln_w + ln_b;
                float v = bf2f(pv0[j]); v += (bf2f(pv1[j]) - v) * mu_v;
                (Y + row * D + 512 + h * 64)[ulane] = f2bf((yn + bon[j] * v) * bf2f(gq[j]));
            }
        }
    }
    __syncthreads();
}

constexpr int HC = 32;
__device__ __forceinline__ void hgrn_bh(const Ctx& F, int b, int h) {
    const bf16_t* proj = (const bf16_t*)(F.ws + WS_BIG); const float* lb = (const float*)(F.ws + WS_LB);
    bf16_t* Y = (bf16_t*)(F.ws + WS_HB);
    LAS float* Ql = (LAS float*)F.lds; LAS float* Fl = Ql + HC * 128; LAS float* Il = Fl + HC * 128; LAS float* Ol = Il + HC * 128;
    const int tid = (F.wid * 64 + lane_id_()), lane = lane_id_(), w = F.wid, kg = lane & 15, vq = lane >> 4;
    const int pk_ = tid & 127; const float lbk = lb[h * 128 + pk_];
    const float gn0 = F_hg_norm[lane], gn1 = F_hg_norm[64 + lane];
    float st[8][4];
#pragma unroll
    for (int i = 0; i < 8; ++i)
#pragma unroll
        for (int j = 0; j < 4; ++j) st[i][j] = 0.f;
    for (int ch = 0; ch < S / HC; ++ch) {
        const int t0 = ch * HC;
#pragma unroll
        for (int i = 0; i < HC / 4; ++i) {
            const int tl = (tid >> 7) + 4 * i; const size_t row = (size_t)b * S + t0 + tl;
            const bf16_t* p = proj + row * IN_ODD + h * 128 + pk_;
            Ql[tl * 128 + pk_] = siluf_(bf2f(p[0])); Fl[tl * 128 + pk_] = lbk + (1.0f - lbk) * sigmoidf_(bf2f(p[1024])); Il[tl * 128 + pk_] = bf2f(p[2048]);
        }
        __syncthreads();
#pragma unroll 2
        for (int tl = 0; tl < HC; ++tl) {
            const f32x4 f0 = *(const LAS f32x4*)(Fl + tl * 128 + 8 * kg), f1 = *(const LAS f32x4*)(Fl + tl * 128 + 8 * kg + 4);
            const f32x4 q0 = *(const LAS f32x4*)(Ql + tl * 128 + 8 * kg), q1 = *(const LAS f32x4*)(Ql + tl * 128 + 8 * kg + 4);
            const f32x4 i4 = *(const LAS f32x4*)(Il + tl * 128 + 16 * w + 4 * vq);
            f32x4 o = {0.f, 0.f, 0.f, 0.f};
#pragma unroll
            for (int kk = 0; kk < 8; ++kk) { const float f = kk < 4 ? f0[kk & 3] : f1[kk & 3], q = kk < 4 ? q0[kk & 3] : q1[kk & 3], kv = 1.0f - f;
#pragma unroll
                for (int vv = 0; vv < 4; ++vv) { st[kk][vv] = st[kk][vv] * f + kv * i4[vv]; o[vv] += q * st[kk][vv]; } }
#pragma unroll
            for (int vv = 0; vv < 4; ++vv) o[vv] = reduce16(o[vv]);
            if (kg == 0) *(LAS f32x4*)(Ol + tl * 128 + 16 * w + 4 * vq) = o;
        }
        __syncthreads();
#pragma unroll
        for (int i = 0; i < HC / 8; ++i) {
            const int tl = w + 8 * i; const size_t row = (size_t)b * S + t0 + tl;
            const float oa = Ol[tl * 128 + lane], ob = Ol[tl * 128 + 64 + lane];
            const float rstd = 1.0f / sqrtf(wave_sum(oa * oa + ob * ob) * (1.0f / 128.f) + 1e-6f);
            const bf16_t* gp = proj + row * IN_ODD + 3072 + h * 128;
            Y[row * D + h * 128 + lane] = f2bf(oa * rstd * gn0 * siluf_(bf2f(gp[lane])));
            Y[row * D + h * 128 + 64 + lane] = f2bf(ob * rstd * gn1 * siluf_(bf2f(gp[64 + lane])));
        }
        __syncthreads();
    }
}


constexpr int HQP = 272, HTP = 80, HOP = 528;
constexpr int H_QM = 0, H_KM = 8704, H_KD = 17408, H_VT = 27648, H_EM = 37888, H_EL = 38400, H_PART = 38912, H_O = 40960;
__device__ __forceinline__ bf16x8 ld_frag2(const LAS unsigned char* p) { const u32x2 a = *(const LAS u32x2*)p, b = *(const LAS u32x2*)(p + 32); const u32x4 v = {a.x, a.y, b.x, b.y}; return __builtin_bit_cast(bf16x8, v); }
__device__ __forceinline__ bf16x8 pack8(const f32x4 a, const f32x4 b) { const u32x4 v = {pk2(a[0], a[1]), pk2(a[2], a[3]), pk2(b[0], b[1]), pk2(b[2], b[3])}; return __builtin_bit_cast(bf16x8, v); }
__device__ __forceinline__ void hgrn_chunked_bh(const Ctx& F, int b, int h) {
    const bf16_t* proj = (const bf16_t*)(F.ws + WS_BIG); const float* lb = (const float*)(F.ws + WS_LB);
    bf16_t* Y = (bf16_t*)(F.ws + WS_HB);
    LAS unsigned char* L = F.lds;
    const int lane = lane_id_(), w = F.wid, tid = w * 64 + lane, c16 = lane & 15, g = lane >> 4;
    const int pt = lane & 31, phalf = lane >> 5, k0 = 16 * w + 8 * phalf;
    float lb8[8];
    { const f32x4 l0 = *(const f32x4*)(lb + h * 128 + k0), l1 = *(const f32x4*)(lb + h * 128 + k0 + 4); lb8[0] = l0[0]; lb8[1] = l0[1]; lb8[2] = l0[2]; lb8[3] = l0[3]; lb8[4] = l1[0]; lb8[5] = l1[1]; lb8[6] = l1[2]; lb8[7] = l1[3]; }
    const float gn0 = F_hg_norm[lane], gn1 = F_hg_norm[64 + lane];
    f32x4 st[8];
#pragma unroll
    for (int i = 0; i < 8; ++i) st[i] = (f32x4){0.f, 0.f, 0.f, 0.f};
    u32x4 rq, rf, rv;
    { const bf16_t* p = proj + ((size_t)b * S + pt) * IN_ODD + h * 128 + k0; rq = *(const u32x4*)p; rf = *(const u32x4*)(p + 1024); rv = *(const u32x4*)(p + 2048); }
    for (int c = 0; c < S / 32; ++c) {
        {
            float q[8], fv[8], Bv[8], kk[8];
            unpack8(rq, q); unpack8(rf, fv);
#pragma unroll
            for (int e = 0; e < 8; ++e) {
                const float f = lb8[e] + (1.0f - lb8[e]) * sigmoidf_(fv[e]); kk[e] = 1.0f - f;
                float x = __logf(f);
                x += __int_as_float(__builtin_amdgcn_update_dpp(0, __float_as_int(x), 0x111, 0xf, 0xf, false));
                x += __int_as_float(__builtin_amdgcn_update_dpp(0, __float_as_int(x), 0x112, 0xf, 0xf, false));
                x += __int_as_float(__builtin_amdgcn_update_dpp(0, __float_as_int(x), 0x114, 0xf, 0xf, false));
                x += __int_as_float(__builtin_amdgcn_update_dpp(0, __float_as_int(x), 0x118, 0xf, 0xf, false));
                x += __int_as_float(__builtin_amdgcn_update_dpp(0, __float_as_int(x), 0x142, 0xa, 0xf, false));
                Bv[e] = x;
            }
            LAS float* PW = (LAS float*)(L + H_PART);
            if (pt == 15) { *(LAS f32x4*)(PW + k0) = (f32x4){Bv[0], Bv[1], Bv[2], Bv[3]}; *(LAS f32x4*)(PW + k0 + 4) = (f32x4){Bv[4], Bv[5], Bv[6], Bv[7]}; }
            if (pt == 31) { *(LAS f32x4*)(PW + 128 + k0) = (f32x4){Bv[0], Bv[1], Bv[2], Bv[3]}; *(LAS f32x4*)(PW + 128 + k0 + 4) = (f32x4){Bv[4], Bv[5], Bv[6], Bv[7]}; }
            asm volatile("s_waitcnt lgkmcnt(0)" ::: "memory");
            const f32x4 m0 = *(const LAS f32x4*)(PW + k0), m1 = *(const LAS f32x4*)(PW + k0 + 4), e0 = *(const LAS f32x4*)(PW + 128 + k0), e1 = *(const LAS f32x4*)(PW + 128 + k0 + 4);
            float qm[8], km[8], kd[8];
#pragma unroll
            for (int e = 0; e < 8; ++e) { const float bmid = e < 4 ? m0[e & 3] : m1[e & 3], blast = e < 4 ? e0[e & 3] : e1[e & 3];
                const float ex = __expf(fminf(fmaxf(Bv[e] - bmid, -60.f), 60.f));
                qm[e] = q[e] * ex; km[e] = kk[e] * __builtin_amdgcn_rcpf(ex); kd[e] = km[e] * __expf(blast - bmid);
                if (pt == 31) { ((LAS float*)(L + H_EM))[k0 + e] = __expf(bmid); ((LAS float*)(L + H_EL))[k0 + e] = __expf(blast); } }
            *(LAS u32x4*)(L + H_QM + pt * HQP + 2 * k0) = (u32x4){pk2(qm[0], qm[1]), pk2(qm[2], qm[3]), pk2(qm[4], qm[5]), pk2(qm[6], qm[7])};
            *(LAS u32x4*)(L + H_KM + pt * HQP + 2 * k0) = (u32x4){pk2(km[0], km[1]), pk2(km[2], km[3]), pk2(km[4], km[5]), pk2(km[6], km[7])};
#pragma unroll
            for (int e = 0; e < 8; ++e) { *(LAS bf16_t*)(L + H_KD + (k0 + e) * HTP + 2 * pt) = f2bf(kd[e]);
                const unsigned wv = rv[e >> 1]; *(LAS bf16_t*)(L + H_VT + (k0 + e) * HTP + 2 * pt) = (bf16_t)((e & 1) ? (wv >> 16) : (wv & 0xffffu)); }
        }
        if (c + 1 < S / 32) { const bf16_t* p = proj + ((size_t)b * S + 32 * (c + 1) + pt) * IN_ODD + h * 128 + k0; rq = *(const u32x4*)p; rf = *(const u32x4*)(p + 1024); rv = *(const u32x4*)(p + 2048); }
        bf16_t gq[4][2];
#pragma unroll
        for (int i = 0; i < 4; ++i) { const bf16_t* gp = proj + ((size_t)b * S + 32 * c + w + 8 * i) * IN_ODD + 3072 + h * 128; gq[i][0] = gp[lane]; gq[i][1] = gp[64 + lane]; }
        __syncthreads();
        {
            bf16x8 qf[4][2];
#pragma unroll
            for (int s = 0; s < 4; ++s)
#pragma unroll
                for (int nt = 0; nt < 2; ++nt) qf[s][nt] = ld_frag2(L + H_QM + (c16 + 16 * nt) * HQP + (32 * s + 4 * g) * 2);
            f32x4 at[2][2];
#pragma unroll
            for (int mt = 0; mt < 2; ++mt)
#pragma unroll
                for (int nt = 0; nt < 2; ++nt) at[mt][nt] = (f32x4){0.f, 0.f, 0.f, 0.f};
#pragma unroll
            for (int s = 0; s < 4; ++s)
#pragma unroll
                for (int mt = 0; mt < 2; ++mt) { const bf16x8 ka = ld_frag2(L + H_KM + (c16 + 16 * mt) * HQP + (32 * s + 4 * g) * 2);
#pragma unroll
                    for (int nt = 0; nt < 2; ++nt) at[mt][nt] = __builtin_amdgcn_mfma_f32_16x16x32_bf16(ka, qf[s][nt], at[mt][nt], 0, 0, 0); }
#pragma unroll
            for (int mt = 0; mt < 2; ++mt)
#pragma unroll
                for (int nt = 0; nt < 2; ++nt)
#pragma unroll
                    for (int r = 0; r < 4; ++r) if (16 * mt + 4 * g + r > c16 + 16 * nt) at[mt][nt][r] = 0.f;
            f32x4 oT[2] = {(f32x4){0.f, 0.f, 0.f, 0.f}, (f32x4){0.f, 0.f, 0.f, 0.f}};
#pragma unroll
            for (int s = 0; s < 4; ++s) {
                const f32x4 e0 = *(const LAS f32x4*)(L + H_EM + (32 * s + 4 * g) * 4), e1 = *(const LAS f32x4*)(L + H_EM + (32 * s + 16 + 4 * g) * 4);
                const bf16x8 sA = pack8(st[2 * s] * e0, st[2 * s + 1] * e1);
#pragma unroll
                for (int nt = 0; nt < 2; ++nt) oT[nt] = __builtin_amdgcn_mfma_f32_16x16x32_bf16(sA, qf[s][nt], oT[nt], 0, 0, 0);
            }
            const bf16x8 vA = ld_frag2(L + H_VT + (16 * w + c16) * HTP + 8 * g);
#pragma unroll
            for (int nt = 0; nt < 2; ++nt) oT[nt] = __builtin_amdgcn_mfma_f32_16x16x32_bf16(vA, pack8(at[0][nt], at[1][nt]), oT[nt], 0, 0, 0);
#pragma unroll
            for (int mt = 0; mt < 8; ++mt) { const f32x4 el = *(const LAS f32x4*)(L + H_EL + (16 * mt + 4 * g) * 4);
                const bf16x8 kdA = ld_frag2(L + H_KD + (16 * mt + c16) * HTP + 8 * g);
                st[mt] = __builtin_amdgcn_mfma_f32_16x16x32_bf16(kdA, vA, st[mt] * el, 0, 0, 0); }
#pragma unroll
            for (int nt = 0; nt < 2; ++nt) *(LAS f32x4*)(L + H_O + (c16 + 16 * nt) * HOP + (16 * w + 4 * g) * 4) = oT[nt];
        }
        __syncthreads();
#pragma unroll
        for (int i = 0; i < 4; ++i) {
            const int tl = w + 8 * i; const size_t row = (size_t)b * S + 32 * c + tl;
            const float oa = *(const LAS float*)(L + H_O + tl * HOP + 4 * lane), ob = *(const LAS float*)(L + H_O + tl * HOP + 4 * (64 + lane));
            const float rstd = 1.0f / sqrtf(wave_sum(oa * oa + ob * ob) * (1.0f / 128.f) + 1e-6f);
            Y[row * D + h * 128 + lane] = f2bf(oa * rstd * gn0 * bf2f(gq[i][0]));
            Y[row * D + h * 128 + 64 + lane] = f2bf(ob * rstd * gn1 * bf2f(gq[i][1]));
        }
    }
    __syncthreads();
}

__device__ __forceinline__ void final_norm_phase(const Ctx& F) {
    const int ln = lane_id_();
    const bf16_t* xf = (const bf16_t*)(F.ws + WS_XF);
    const int gw = F.bid * NWAVES + F.wid, NGW = F.G * NWAVES;
    float ga[2][8];
#pragma unroll
    for (int j = 0; j < 2; ++j)
#pragma unroll
        for (int h = 0; h < 2; ++h) { const f32x4 g = *(const f32x4*)(F_final_norm + 8 * ln + 512 * j + 4 * h);
#pragma unroll
            for (int e = 0; e < 4; ++e) ga[j][4 * h + e] = g[e]; }
    for (int ch = gw; ch < T / 4; ch += NGW) {
        u32x4 raw[4][2]; float s[4];
#pragma unroll
        for (int u = 0; u < 4; ++u)
#pragma unroll
            for (int j = 0; j < 2; ++j) raw[u][j] = *(const u32x4*)(xf + (size_t)(4 * ch + u) * D + 8 * ln + 512 * j);
#pragma unroll
        for (int u = 0; u < 4; ++u) { s[u] = 0.f;
#pragma unroll
            for (int j = 0; j < 2; ++j) { float f[8]; unpack8(raw[u][j], f);
#pragma unroll
                for (int e = 0; e < 8; ++e) s[u] += f[e] * f[e]; }
            s[u] = wave_sum_fast(s[u]); }
#pragma unroll
        for (int u = 0; u < 4; ++u) { const float rstd = 1.0f / sqrtf(s[u] * (1.0f / D) + 1e-6f); float* xr = F.out + (size_t)(4 * ch + u) * D;
#pragma unroll
            for (int j = 0; j < 2; ++j) { float f[8]; unpack8(raw[u][j], f);
                *(f32x4*)(xr + 8 * ln + 512 * j) = (f32x4){f[0] * rstd * ga[j][0], f[1] * rstd * ga[j][1], f[2] * rstd * ga[j][2], f[3] * rstd * ga[j][3]};
                *(f32x4*)(xr + 8 * ln + 512 * j + 4) = (f32x4){f[4] * rstd * ga[j][4], f[5] * rstd * ga[j][5], f[6] * rstd * ga[j][6], f[7] * rstd * ga[j][7]}; } }
    }
}

#define XB_TMO      128
#define XB_XCNT(j)  (256  + 64 * (j))
#define XB_XSUB(j)  (1280 + 64 * (j))
#define XB_XGEN(j)  (2304 + 64 * (j))
#define XB_TOP      3328
#define XB_TOPGEN   3392
#define XCD_BAR_WORDS 3456
#define XB_SPIN_CAP (1u << 22)
__device__ __forceinline__ unsigned xb_ld(unsigned* p)              { return __hip_atomic_load(p, __ATOMIC_RELAXED, __HIP_MEMORY_SCOPE_AGENT); }
__device__ __forceinline__ unsigned xb_add(unsigned* p, unsigned v) { return __hip_atomic_fetch_add(p, v, __ATOMIC_RELAXED, __HIP_MEMORY_SCOPE_AGENT); }
__device__ __forceinline__ unsigned xb_xcc_id() { return (unsigned)__builtin_amdgcn_s_getreg((3 << 11) | 20) & 0xFu; }
#define XB_SPIN(cond, bar) do { unsigned _sp = 0; while (cond) { __builtin_amdgcn_s_sleep(1); \
    if ((++_sp & 255u) == 0u) { if (xb_ld(&(bar)[XB_TMO])) break; if (_sp > XB_SPIN_CAP) { atomicAdd(&(bar)[XB_TMO], 1u); break; } } } } while (0)
__device__ __forceinline__ void xcd_barrier_complete(unsigned* bar, unsigned x, unsigned& nloc, unsigned& nx) {
    const unsigned G = gridDim.x;
    unsigned sum, cnt, mine, sp = 0u;
    for (;;) {
        sum = 0u; cnt = 0u; mine = 0u;
#pragma unroll
        for (unsigned j = 0; j < 16; ++j) { const unsigned c = xb_ld(&bar[XB_XCNT(j)]); sum += c; cnt += (c > 0u) ? 1u : 0u; mine = (j == x) ? c : mine; }
        if (sum == G) break;
        __builtin_amdgcn_s_sleep(1);
        if ((++sp & 255u) == 0u) { if (xb_ld(&bar[XB_TMO])) break; if (sp > XB_SPIN_CAP) { atomicAdd(&bar[XB_TMO], 1u); break; } }
    }
    nloc = mine > 0u ? mine : 1u; nx = cnt > 0u ? cnt : 1u;
}
__device__ __forceinline__ void grid_bar(const Ctx& F, unsigned) {
    asm volatile("s_waitcnt vmcnt(0) lgkmcnt(0)" ::: "memory");
    __syncthreads();
    if (F.wid == 0) {
        if (lane_id_() == 0) {
            unsigned* bar = (unsigned*)(F.ws + WS_BAR);
            volatile LAS unsigned* st = (volatile LAS unsigned*)(F.lds + LDS_BYTES - 64);
            const unsigned x = xb_xcc_id();
            __builtin_amdgcn_s_waitcnt(0);
            unsigned nloc = st[0], nx = st[1];
            if (nloc == 0u) { xcd_barrier_complete(bar, x, nloc, nx); st[0] = nloc; st[1] = nx; }
            const unsigned old = xb_add(&bar[XB_XSUB(x)], 1u);
            const unsigned gen = old / nloc;
            if (old + 1u == (gen + 1u) * nloc) {
                __builtin_amdgcn_fence(__ATOMIC_RELEASE, "agent");
                asm volatile("s_waitcnt vmcnt(0)" ::: "memory");
                const unsigned og = xb_add(&bar[XB_TOP], 1u);
                const unsigned tg = og / nx;
                if (og + 1u == (tg + 1u) * nx) xb_add(&bar[XB_TOPGEN], 1u);
                else XB_SPIN(xb_ld(&bar[XB_TOPGEN]) == tg, bar);
                __builtin_amdgcn_fence(__ATOMIC_ACQUIRE, "agent");
                xb_add(&bar[XB_XGEN(x)], 1u);
                asm volatile("s_waitcnt vmcnt(0)" ::: "memory");
            } else {
                XB_SPIN(xb_ld(&bar[XB_XGEN(x)]) == gen, bar);
                __builtin_amdgcn_fence(__ATOMIC_ACQUIRE, "agent");
                asm volatile("s_waitcnt vmcnt(0)" ::: "memory");
            }
        }
    }
    __syncthreads();
}

__global__ void __launch_bounds__(NTHREADS) fwd_mega(Args args) {
    extern __shared__ __attribute__((aligned(16))) unsigned char lds_raw[];
    cg::grid_group grid = cg::this_grid();
    Ctx F;
    F.lds = (LAS unsigned char*)lds_raw; F.G = gridDim.x; F.bid = blockIdx.x; F.wid = __builtin_amdgcn_readfirstlane(threadIdx.x >> 6);
    F.out = args.out; F.ws = args.ws;
    unsigned char* ws = args.ws;
    if (threadIdx.x < 2) ((LAS unsigned*)(F.lds + LDS_BYTES - 64))[threadIdx.x] = 0u;
    if (threadIdx.x == 0) (void)xb_add((unsigned*)(ws + WS_BAR) + XB_XCNT(xb_xcc_id()), 1u);
    __syncthreads();
    const float* mod = (const float*)(ws + WS_MOD);
    bf16_t* HB = (bf16_t*)(ws + WS_HB); bf16_t* BIG = (bf16_t*)(ws + WS_BIG);
    bf16_t* XA = (bf16_t*)args.out; bf16_t* XF = (bf16_t*)(ws + WS_XF);
    const int lo = args.ph_lo, hi = args.ph_hi;
    int ph = 0; unsigned nbar = 0;
#define PHASE_BEGIN if (lo <= ph && ph < hi) { { unsigned long long ta_ = (unsigned long long)__builtin_amdgcn_kernarg_segment_ptr(); asm volatile("" : "+s"(ta_)); F.in = (const __attribute__((address_space(4))) unsigned long long*)ta_; }
#define PHASE_END   if (ph + 1 < hi) { if (ph == 0) grid.sync(); else for (int rb = 0; rb < REP_BAR; ++rb) grid_bar(F, (++nbar) * (unsigned)F.G); } } ++ph;
    pg8::StaticOrder SO;

#ifndef REP_NORM
#define REP_NORM 1
#endif
#ifndef REP_GEMM
#define REP_GEMM 1
#endif
#ifndef REP_P0
#define REP_P0 1
#endif
#ifndef REP_BAR
#define REP_BAR 1
#endif
#ifndef REP_ATTN
#define REP_ATTN 1
#endif
#ifndef REP_RWKV
#define REP_RWKV 1
#endif
#ifndef REP_HGRN
#define REP_HGRN 1
#endif
    PHASE_BEGIN for (int rep = 0; rep < REP_P0; ++rep) p0_prologue(F); PHASE_END
    PHASE_BEGIN for (int rep = 0; rep < REP_NORM; ++rep) norm_mod_phase(F, F_x, F_norm_mix, mod + 0 * 1024, mod + 1 * 1024); PHASE_END
    PHASE_BEGIN { pg8::Gemm g{HB, (const bf16_t*)(ws + WS_WINE)}; SO.init(T, IN_EVEN_P, F.G, F.bid);
        pg8::EpiBf16 E{BIG, IN_EVEN_P}; for (int rep = 0; rep < REP_GEMM; ++rep) pg8::gemm_phase<pg8::EpiBf16, true, 1024, 1024, 1024>(F.lds, F.wid, g, SO, E); } PHASE_END
    PHASE_BEGIN for (int rep = 0; rep < REP_NORM; ++rep) prep_even_phase(F); PHASE_END
    PHASE_BEGIN {
        { pg8::Gemm g{BIG, (const bf16_t*)(ws + WS_WUQ)}; SO.init(T, 768, F.G, F.bid);
          pg8::EpiQ E{(bf16_t*)(ws + WS_Q), (const float*)(ws + WS_STATS), (const float*)(ws + WS_CS)}; pg8::gemm_phase<pg8::EpiQ, true, 384, IN_EVEN_P, 384>(F.lds, F.wid, g, SO, E); }
        { pg8::Gemm g{BIG + 384, (const bf16_t*)(ws + WS_WUKV)}; SO.init(T, 1024, F.G, F.bid);
          pg8::EpiKV E{(bf16_t*)(ws + WS_KH), (bf16_t*)(ws + WS_VH), (const float*)(ws + WS_STATS)}; pg8::gemm_phase<pg8::EpiKV, true, 256, IN_EVEN_P, 256>(F.lds, F.wid, g, SO, E); }
        { pg8::Gemm g{(const bf16_t*)(ws + WS_AP), (const bf16_t*)(ws + WS_WLORA)}; SO.init(T, 1536, F.G, F.bid);
          pg8::EpiBf16 E{(bf16_t*)(ws + WS_LORA), 1536}; pg8::gemm_phase<pg8::EpiBf16, true, 256, 256, 256>(F.lds, F.wid, g, SO, E); }
    } PHASE_END
    PHASE_BEGIN { for (int it = F.bid; it < 256; it += F.G) for (int rep = 0; rep < REP_ATTN; ++rep) attn_bh(F, it >> 3, it & 7);
                  asm volatile("" ::: "memory");
                  for (int it = F.bid; it < 256; it += F.G) for (int rep = 0; rep < REP_RWKV; ++rep) rwkv_chunked_bh(F, it >> 3, it & 7); } PHASE_END
    PHASE_BEGIN { pg8::Gemm g{HB, (const bf16_t*)(ws + WS_WOUTE)}; SO.init(T, 1024, F.G, F.bid);
        pg8::EpiRes<false> E{F_x, XA, mod + 2 * 1024}; pg8::gemm_phase<pg8::EpiRes<false>, true, 1024, 1024, 1024>(F.lds, F.wid, g, SO, E); } PHASE_END
    PHASE_BEGIN for (int rep = 0; rep < REP_NORM; ++rep) norm_mod_bf16_phase(F, XA, F_norm_ffn, mod + 3 * 1024, mod + 4 * 1024); PHASE_END
    PHASE_BEGIN { pg8::Gemm g{HB, (const bf16_t*)(ws + WS_WGU)}; SO.init(T, 2 * FF, F.G, F.bid);
        pg8::EpiSwiglu E{BIG}; for (int rep = 0; rep < REP_GEMM; ++rep) pg8::gemm_phase<pg8::EpiSwiglu, true, 1024, 1024, 1024>(F.lds, F.wid, g, SO, E); } PHASE_END
    PHASE_BEGIN { pg8::Gemm g{BIG, (const bf16_t*)(ws + WS_WD)}; SO.init(T, 1024, F.G, F.bid);
        pg8::EpiRes<true> E{XA, XA, mod + 5 * 1024}; pg8::gemm_phase<pg8::EpiRes<true>, true, FF, FF, FF>(F.lds, F.wid, g, SO, E); } PHASE_END
    const float* mod1 = mod + (size_t)32 * 6144;
    PHASE_BEGIN for (int rep = 0; rep < REP_NORM; ++rep) norm_mod_bf16_phase(F, XA, F_norm_mix + 1024, mod1 + 0 * 1024, mod1 + 1 * 1024); PHASE_END
    PHASE_BEGIN { pg8::Gemm g{HB, (const bf16_t*)(ws + WS_WINO)}; SO.init(T, IN_ODD, F.G, F.bid);
        pg8::EpiOdd E{BIG}; for (int rep = 0; rep < REP_GEMM; ++rep) pg8::gemm_phase<pg8::EpiOdd, true, 1024, 1024, 1024>(F.lds, F.wid, g, SO, E); } PHASE_END
    PHASE_BEGIN for (int it = F.bid; it < 256; it += F.G) for (int rep = 0; rep < REP_HGRN; ++rep) hgrn_chunked_bh(F, it >> 3, it & 7); PHASE_END
    PHASE_BEGIN { pg8::Gemm g{HB, (const bf16_t*)(ws + WS_WOUTO)}; SO.init(T, 1024, F.G, F.bid);
        pg8::EpiRes<true> E{XA, XA, mod1 + 2 * 1024}; pg8::gemm_phase<pg8::EpiRes<true>, true, 1024, 1024, 1024>(F.lds, F.wid, g, SO, E); } PHASE_END
    PHASE_BEGIN for (int rep = 0; rep < REP_NORM; ++rep) norm_mod_bf16_phase(F, XA, F_norm_ffn + 1024, mod1 + 3 * 1024, mod1 + 4 * 1024); PHASE_END
    PHASE_BEGIN { pg8::Gemm g{HB, (const bf16_t*)(ws + WS_WGU) + (size_t)5632 * 1024}; SO.init(T, 2 * FF, F.G, F.bid);
        pg8::EpiSwiglu E{BIG}; for (int rep = 0; rep < REP_GEMM; ++rep) pg8::gemm_phase<pg8::EpiSwiglu, true, 1024, 1024, 1024>(F.lds, F.wid, g, SO, E); } PHASE_END
    PHASE_BEGIN { pg8::Gemm g{BIG, (const bf16_t*)(ws + WS_WD) + (size_t)1024 * FF}; SO.init(T, 1024, F.G, F.bid);
        pg8::EpiRes<true> E{XA, XF, mod1 + 5 * 1024}; pg8::gemm_phase<pg8::EpiRes<true>, true, FF, FF, FF>(F.lds, F.wid, g, SO, E); } PHASE_END
    PHASE_BEGIN final_norm_phase(F); PHASE_END
}
constexpr int N_PHASES = 18;

extern "C" void kernel_launch(void* const* d_in, const int* in_sizes, int n_in, void* d_out, int out_size, void* d_ws, size_t ws_size, hipStream_t stream) {
    static int grid = 0;
    if (grid == 0) {
        if (n_in != 32 || out_size != T * D || ws_size < WS_END) { fprintf(stderr, "kernel_launch: unexpected shapes (n_in %d out %d ws %zu)\n", n_in, out_size, ws_size); grid = -1; return; }
        int dev = 0, cus = 0, per_cu = 0;
        (void)hipGetDevice(&dev); (void)hipDeviceGetAttribute(&cus, hipDeviceAttributeMultiprocessorCount, dev);
        if (hipFuncSetAttribute((const void*)fwd_mega, hipFuncAttributeMaxDynamicSharedMemorySize, LDS_BYTES) != hipSuccess) { fprintf(stderr, "kernel_launch: hipFuncSetAttribute failed\n"); grid = -1; return; }
        if (hipOccupancyMaxActiveBlocksPerMultiprocessor(&per_cu, (const void*)fwd_mega, NTHREADS, LDS_BYTES) != hipSuccess || per_cu < 1) { fprintf(stderr, "kernel_launch: occupancy query says %d\n", per_cu); per_cu = 1; }
        (void)hipGetLastError();
        grid = cus > 0 ? cus : 256;
    }
    if (grid < 0) return;
    (void)hipMemsetAsync((unsigned char*)d_ws + WS_BAR, 0, XCD_BAR_WORDS * 4, stream);
    Args a{};
    for (int i = 0; i < 32; ++i) a.in[i] = d_in[i];
    a.out = (float*)d_out; a.ws = (unsigned char*)d_ws; a.ph_lo = 0; a.ph_hi = N_PHASES;
    void* kargs[] = {&a};
    hipError_t e = hipLaunchCooperativeKernel((const void*)fwd_mega, dim3(grid), dim3(NTHREADS), kargs, LDS_BYTES, stream);
    if (e != hipSuccess) fprintf(stderr, "cooperative launch failed: %s (grid %d)\n", hipGetErrorString(e), grid);
}
```

```cpp
#include <hip/hip_runtime.h>
#include <hip/hip_cooperative_groups.h>
#include <cstdio>
#include <cstdint>
namespace cg = cooperative_groups;

#define LAS __attribute__((address_space(3)))
typedef unsigned short bf16_t;
typedef short bf16x8 __attribute__((ext_vector_type(8)));
typedef float f32x4 __attribute__((ext_vector_type(4)));
typedef float f32x2 __attribute__((ext_vector_type(2)));
typedef float f32x16 __attribute__((ext_vector_type(16)));
typedef unsigned u32x4 __attribute__((ext_vector_type(4)));
typedef unsigned u32x2 __attribute__((ext_vector_type(2)));
typedef __bf16 bf16x2_t __attribute__((ext_vector_type(2)));

constexpr int D = 1024, NB = 32, S = 2048, T = NB * S;
constexpr int IN_EVEN = 2464, IN_EVEN_P = 2560, RW_OFF = 672;
constexpr int FF = 2816, IN_ODD = 4096;
constexpr int NTHREADS = 512, NWAVES = 8;
constexpr int LDS_BYTES = 147456;
constexpr float QSCALE = 0.10206207261596577f * 1.4426950408889634f;

constexpr size_t MiB = 1u << 20;
constexpr size_t WS_MOD = 0;
constexpr size_t WS_LB = 2 * MiB;
constexpr size_t WS_BAR = 3 * MiB;
constexpr size_t WS_WINE = 4 * MiB;
constexpr size_t WS_WUQ = 9 * MiB;
constexpr size_t WS_WUKV = 10 * MiB;
constexpr size_t WS_WLORA = 11 * MiB;
constexpr size_t WS_WOUTE = 12 * MiB;
constexpr size_t WS_WINO = 14 * MiB;
constexpr size_t WS_WOUTO = 22 * MiB;
constexpr size_t WS_WGU = 24 * MiB;
constexpr size_t WS_WD = 46 * MiB;
constexpr size_t WS_STATS = 57 * MiB;
constexpr size_t WS_CS = 58 * MiB;
constexpr size_t WS_HB = 66 * MiB;
constexpr size_t WS_BIG = 194 * MiB;
constexpr size_t WS_Q = 514 * MiB;
constexpr size_t WS_KH = 610 * MiB;
constexpr size_t WS_KR = 674 * MiB;
constexpr size_t WS_VH = 706 * MiB;
constexpr size_t WS_AP = 770 * MiB;
constexpr size_t WS_LORA = 802 * MiB;
constexpr size_t WS_XF = 706 * MiB;
constexpr size_t WS_END = 994 * MiB;

__device__ __forceinline__ float bf2f(bf16_t v) { return __uint_as_float(((unsigned)v) << 16); }
__device__ __forceinline__ unsigned pk2(float lo, float hi) { f32x2 v = {lo, hi}; bf16x2_t b = __builtin_convertvector(v, bf16x2_t); return __builtin_bit_cast(unsigned, b); }
__device__ __forceinline__ bf16_t f2bf(float f) { return (bf16_t)(pk2(f, 0.f) & 0xffffu); }
__device__ __forceinline__ float sigmoidf_(float x) { return __builtin_amdgcn_rcpf(1.f + __expf(-x)); }
__device__ __forceinline__ float siluf_(float x) { return x * sigmoidf_(x); }
__device__ __forceinline__ float wave_sum(float v) {
#pragma unroll
    for (int o = 1; o < 64; o <<= 1) v += __shfl_xor(v, o);
    return v;
}
__device__ __forceinline__ float rl_(float x, int l) { return __int_as_float(__builtin_amdgcn_readlane(__float_as_int(x), l)); }
template <int CTRL> __device__ __forceinline__ float dpp_f(float x) { return __int_as_float(__builtin_amdgcn_mov_dpp(__float_as_int(x), CTRL, 0xf, 0xf, true)); }
__device__ __forceinline__ float reduce16(float x) {
    x += dpp_f<0xB1>(x);
    x += dpp_f<0x4E>(x);
    x += dpp_f<0x141>(x);
    x += dpp_f<0x140>(x);
    return x;
}

__device__ __forceinline__ int lane_id_() { int l; asm volatile("v_mbcnt_lo_u32_b32 %0, -1, 0\n\tv_mbcnt_hi_u32_b32 %0, -1, %0" : "=v"(l)); return l; }
__device__ __forceinline__ float wave_sum_fast(float x) { x = reduce16(x); return (rl_(x, 0) + rl_(x, 16)) + (rl_(x, 32) + rl_(x, 48)); }
namespace pg8 {
constexpr int BM = 256, BK = 64, HALF = 128, HTB = HALF * BK * 2, STAGE_BYTES = 8 * HTB, NXCD = 8, WGM = 8;
__host__ __device__ __forceinline__ int lds_byte(int r, int c) { const int st = (r >> 4) * 2 + (c >> 5), rr = r & 15, cc = c & 31, ob = rr * 64 + cc * 2; return st * 1024 + (ob ^ (((ob >> 9) & 1) << 5)); }
__host__ __device__ __forceinline__ void stage_rc(int b, int& R, int& C) { const int st = b / 1024, sb = b % 1024, swz = sb ^ (((sb >> 9) & 1) << 5); R = (st >> 1) * 16 + swz / 64; C = (st & 1) * 32 + (swz % 64) / 2; }
__host__ __device__ __forceinline__ int perm32(int rho) { const int n = rho >> 4, i = rho & 15; return 8 * (i >> 2) + 4 * n + (i & 3); }
struct Unit { int pm, pn; };
struct Gemm { const bf16_t* A; const bf16_t* Bt; };
struct StaticOrder {
    int nM, nN, nwg, G, c;
    __device__ void init(int M, int N, int G_, int c_) { nM = M / BM; nN = N / BM; nwg = nM * nN; G = G_; c = c_; }
    __device__ bool next(int i, Unit& u) const {
        const long L = (long)i * G + c; if (L >= nwg) return false;
        int wgid = (int)L; { const int q = nwg / NXCD, r = nwg % NXCD, xcd = wgid % NXCD, off = wgid / NXCD; wgid = (xcd < r ? xcd * (q + 1) : r * (q + 1) + (xcd - r) * q) + off; }
        const int nig = WGM * nN, gid = wgid / nig, fm = gid * WGM, gsz = (nM - fm) < WGM ? (nM - fm) : WGM;
        u.pm = fm + ((wgid % nig) % gsz); u.pn = (wgid % nig) / gsz; return true;
    }
};
template <class Epi, bool ALIGN_EPI, int K, int LDA, int LDB>
__device__ __forceinline__ void gemm_phase(LAS unsigned char* lds, const int wid, const Gemm g, const StaticOrder& S, const Epi& E) {
    const int lane = lane_id_(), tid = wid * 64 + lane, wr = wid >> 2, wc = wid & 3, fr = lane & 15, fq = lane >> 4;
    constexpr int nt = K / BK;
    unsigned voffA[2], voffB[2];
#pragma unroll
    for (int i = 0; i < 2; ++i) { int R, C; stage_rc(tid * 16 + i * 8192, R, C); const int Rb = Epi::PERM ? ((R & ~31) + perm32(R & 31)) : R;
        voffA[i] = (unsigned)(R * LDA + C) * 2u; voffB[i] = (unsigned)(Rb * LDB + C) * 2u; }
    constexpr size_t kstep = (size_t)(BK * 2);
    constexpr size_t hA = (size_t)HALF * LDA * 2, hB = (size_t)HALF * LDB * 2;
    constexpr size_t tA = 2 * hA, tB = 2 * hB;
    const unsigned ldsw = (unsigned)wid * 1024u;
    const int aoff = lds_byte(wr * 64 + fr, fq * 8), boff = lds_byte(wc * 32 + fr, fq * 8);
#define PG8_SA(b, h) (((b) * 2 + (h)) * HTB)
#define PG8_SB(b, h) ((4 + (b) * 2 + (h)) * HTB)
#define PG8_STAGE(bufoff, gbase, voff) do { _Pragma("unroll") for (int _i = 0; _i < 2; ++_i) \
        __builtin_amdgcn_global_load_lds((const unsigned*)((const char*)(gbase) + (voff)[_i]), (LAS unsigned*)(lds + (bufoff) + ldsw + _i * 8192), 16, 0, 0); } while (0)
#define PG8_LDA(dst, b, h) do { _Pragma("unroll") for (int m = 0; m < 4; ++m) _Pragma("unroll") for (int k = 0; k < 2; ++k) dst[m][k] = *(const LAS bf16x8*)(lds + PG8_SA(b, h) + aoff + m * 2048 + k * 1024); } while (0)
#define PG8_LDB(dst, b, h) do { _Pragma("unroll") for (int n = 0; n < 2; ++n) _Pragma("unroll") for (int k = 0; k < 2; ++k) dst[n][k] = *(const LAS bf16x8*)(lds + PG8_SB(b, h) + boff + n * 2048 + k * 1024); } while (0)
#define PG8_MMA(ai, bj, At, Bt) do { __builtin_amdgcn_s_setprio(1); _Pragma("unroll") for (int m = 0; m < 4; ++m) _Pragma("unroll") for (int n = 0; n < 2; ++n) _Pragma("unroll") for (int k = 0; k < 2; ++k) \
        acc[ai][bj][m][n] = __builtin_amdgcn_mfma_f32_16x16x32_bf16(Bt[n][k], At[m][k], acc[ai][bj][m][n], 0, 0, 0); __builtin_amdgcn_s_setprio(0); } while (0)
#define PG8_WAIT_V(n) asm volatile("s_waitcnt vmcnt(" #n ")" ::: "memory")
#define PG8_WAIT_L(n) asm volatile("s_waitcnt lgkmcnt(" #n ")" ::: "memory")
#define PG8_BAR __builtin_amdgcn_s_barrier()
#define PG8_SCHED __builtin_amdgcn_sched_barrier(0)
    Unit cur, nxt; int ui = 0;
    if (!S.next(0, cur)) return;
    f32x4 acc[2][2][4][2];
#pragma unroll
    for (int a = 0; a < 2; ++a)
#pragma unroll
        for (int b = 0; b < 2; ++b)
#pragma unroll
            for (int m = 0; m < 4; ++m)
#pragma unroll
                for (int n = 0; n < 2; ++n) acc[a][b][m][n] = (f32x4){0.f, 0.f, 0.f, 0.f};
    bf16x8 At[4][2], B0[2][2], B1[2][2];
    const char* cA = (const char*)g.A + (size_t)cur.pm * tA; const char* cB = (const char*)g.Bt + (size_t)cur.pn * tB;
    PG8_STAGE(PG8_SB(0, 0), cB, voffB); PG8_STAGE(PG8_SB(0, 1), cB + hB, voffB); PG8_STAGE(PG8_SA(0, 0), cA, voffA); PG8_STAGE(PG8_SA(0, 1), cA + hA, voffA);
    if (wr == 1) PG8_BAR;
    PG8_WAIT_V(2); PG8_BAR;
    PG8_STAGE(PG8_SB(1, 0), cB + kstep, voffB); PG8_STAGE(PG8_SA(1, 0), cA + kstep, voffA); PG8_STAGE(PG8_SB(1, 1), cB + hB + kstep, voffB);
    PG8_WAIT_V(6); PG8_BAR;
    for (;;) {
        const bool has_next = S.next(ui + 1, nxt);
        const char* nA = has_next ? (const char*)g.A + (size_t)nxt.pm * tA : cA; const char* nB = has_next ? (const char*)g.Bt + (size_t)nxt.pn * tB : cB;
        for (int t = 0; t < nt; t += 2) {
            const bool last = (t == nt - 2);
            const char* a1 = cA + (size_t)(t + 1) * kstep;
            const char* a2 = last ? nA : cA + (size_t)(t + 2) * kstep; const char* b2 = last ? nB : cB + (size_t)(t + 2) * kstep;
            const char* a3 = a2 + kstep; const char* b3 = b2 + kstep;
            PG8_LDB(B0, 0, 0); PG8_LDB(B1, 0, 1); PG8_SCHED; PG8_LDA(At, 0, 0); PG8_STAGE(PG8_SA(1, 1), a1 + hA, voffA);
            PG8_WAIT_V(8); PG8_WAIT_L(0); PG8_BAR; PG8_MMA(0, 0, At, B0); PG8_MMA(0, 1, At, B1); PG8_BAR; PG8_SCHED;
            PG8_LDA(At, 0, 1); PG8_STAGE(PG8_SB(0, 0), b2, voffB); PG8_STAGE(PG8_SB(0, 1), b2 + hB, voffB); PG8_STAGE(PG8_SA(0, 0), a2, voffA);
            PG8_WAIT_V(8); PG8_WAIT_L(0); PG8_BAR; PG8_MMA(1, 0, At, B0); PG8_MMA(1, 1, At, B1); PG8_BAR; PG8_SCHED;
            PG8_LDB(B0, 1, 0); PG8_LDB(B1, 1, 1); PG8_SCHED; PG8_LDA(At, 1, 0); PG8_STAGE(PG8_SA(0, 1), a2 + hA, voffA);
            PG8_WAIT_V(8); PG8_WAIT_L(0); PG8_BAR; PG8_MMA(0, 0, At, B0); PG8_MMA(0, 1, At, B1); PG8_BAR; PG8_SCHED;
            PG8_LDA(At, 1, 1); PG8_STAGE(PG8_SB(1, 0), b3, voffB); PG8_STAGE(PG8_SB(1, 1), b3 + hB, voffB); PG8_STAGE(PG8_SA(1, 0), a3, voffA);
            PG8_WAIT_V(8); PG8_WAIT_L(0); PG8_BAR; PG8_MMA(1, 0, At, B0); PG8_MMA(1, 1, At, B1); PG8_BAR; PG8_SCHED;
        }
        if constexpr (ALIGN_EPI) { if (wr == 0) PG8_BAR; }
        { const int l2 = lane_id_(); E(acc, cur, wid >> 2, wid & 3, l2 & 15, l2 >> 4); }
        if (!has_next) break;
#pragma unroll
        for (int a = 0; a < 2; ++a)
#pragma unroll
            for (int b = 0; b < 2; ++b)
#pragma unroll
                for (int m = 0; m < 4; ++m)
#pragma unroll
                    for (int n = 0; n < 2; ++n) acc[a][b][m][n] = (f32x4){0.f, 0.f, 0.f, 0.f};
        cur = nxt; cA = nA; cB = nB; ++ui;
        if constexpr (ALIGN_EPI) { if (wr == 1) PG8_BAR; }
    }
    PG8_WAIT_V(0);
    if constexpr (!ALIGN_EPI) { if (wr == 0) PG8_BAR; }
    PG8_BAR;
#undef PG8_SA
#undef PG8_SB
#undef PG8_STAGE
#undef PG8_LDA
#undef PG8_LDB
#undef PG8_MMA
#undef PG8_WAIT_V
#undef PG8_WAIT_L
#undef PG8_BAR
#undef PG8_SCHED
}

struct EpiBf16 {
    static constexpr bool PERM = true;
    bf16_t* O; int ldc;
    __device__ __forceinline__ void operator()(const f32x4 (&acc)[2][2][4][2], const Unit& u, int wr, int wc, int fr, int fq) const {
        const int row0 = u.pm * BM + wr * 64 + fr, col0 = u.pn * BM + wc * 32 + 8 * fq;
#pragma unroll
        for (int ai = 0; ai < 2; ++ai)
#pragma unroll
            for (int m = 0; m < 4; ++m) { bf16_t* rowp = O + (size_t)(row0 + ai * HALF + m * 16) * ldc + col0;
#pragma unroll
                for (int bj = 0; bj < 2; ++bj) { const f32x4 v0 = acc[ai][bj][m][0], v1 = acc[ai][bj][m][1];
                    u32x4 w; w.x = pk2(v0[0], v0[1]); w.y = pk2(v0[2], v0[3]); w.z = pk2(v1[0], v1[1]); w.w = pk2(v1[2], v1[3]);
                    *(u32x4*)(rowp + bj * HALF) = w; } }
    }
};
struct EpiOdd {
    static constexpr bool PERM = true;
    bf16_t* O;
    __device__ __forceinline__ void operator()(const f32x4 (&acc)[2][2][4][2], const Unit& u, int wr, int wc, int fr, int fq) const {
        const int row0 = u.pm * BM + wr * 64 + fr, col0 = u.pn * BM + wc * 32 + 8 * fq; const bool act = (u.pn < 4) || (u.pn >= 12);
#pragma unroll
        for (int ai = 0; ai < 2; ++ai)
#pragma unroll
            for (int m = 0; m < 4; ++m) { bf16_t* rowp = O + (size_t)(row0 + ai * HALF + m * 16) * IN_ODD + col0;
#pragma unroll
                for (int bj = 0; bj < 2; ++bj) { f32x4 v0 = acc[ai][bj][m][0], v1 = acc[ai][bj][m][1];
                    if (act) {
#pragma unroll
                        for (int j = 0; j < 4; ++j) { v0[j] = siluf_(v0[j]); v1[j] = siluf_(v1[j]); } }
                    u32x4 w; w.x = pk2(v0[0], v0[1]); w.y = pk2(v0[2], v0[3]); w.z = pk2(v1[0], v1[1]); w.w = pk2(v1[2], v1[3]);
                    *(u32x4*)(rowp + bj * HALF) = w; } }
    }
};
struct EpiKV {
    static constexpr bool PERM = true;
    bf16_t* Kh; bf16_t* Vh; const float* stats;
    __device__ __forceinline__ void operator()(const f32x4 (&acc)[2][2][4][2], const Unit& u, int wr, int wc, int fr, int fq) const {
        const int row0 = u.pm * BM + wr * 64 + fr;
        float scv[2][4];
#pragma unroll
        for (int ai = 0; ai < 2; ++ai)
#pragma unroll
            for (int m = 0; m < 4; ++m) scv[ai][m] = stats[2 * (row0 + ai * HALF + m * 16) + 1];
#pragma unroll
        for (int ai = 0; ai < 2; ++ai)
#pragma unroll
            for (int m = 0; m < 4; ++m) { const int row = row0 + ai * HALF + m * 16; const int b = row / S, s = row % S; const float sc = scv[ai][m];
#pragma unroll
                for (int bj = 0; bj < 2; ++bj) { const int h = 2 * u.pn + bj; const f32x4 v0 = acc[ai][bj][m][0] * sc, v1 = acc[ai][bj][m][1] * sc;
                    u32x4 w; w.x = pk2(v0[0], v0[1]); w.y = pk2(v0[2], v0[3]); w.z = pk2(v1[0], v1[1]); w.w = pk2(v1[2], v1[3]);
                    const size_t tok = (size_t)(b * 8 + h) * S + s;
                    if (wc < 2) *(u32x4*)(Kh + tok * 64 + wc * 32 + 8 * fq) = w;
                    else        *(u32x4*)(Vh + tok * 64 + (wc - 2) * 32 + 8 * fq) = w; } }
    }
};
struct EpiQ {
    static constexpr bool PERM = false;
    bf16_t* Q; const float* stats; const float* cs;
    __device__ __forceinline__ void operator()(const f32x4 (&acc)[2][2][4][2], const Unit& u, int wr, int wc, int fr, int fq) const {
        const int row0 = u.pm * BM + wr * 64 + fr;
        float scv[2][4];
#pragma unroll
        for (int ai = 0; ai < 2; ++ai)
#pragma unroll
            for (int m = 0; m < 4; ++m) scv[ai][m] = stats[2 * (row0 + ai * HALF + m * 16)];
#pragma unroll
        for (int ai = 0; ai < 2; ++ai)
#pragma unroll
            for (int m = 0; m < 4; ++m) { const int row = row0 + ai * HALF + m * 16; const float sc = scv[ai][m] * QSCALE;
                const f32x4 cv = *(const f32x4*)(cs + (size_t)row * 32 + 4 * fq), sv = *(const f32x4*)(cs + (size_t)row * 32 + 16 + 4 * fq);
#pragma unroll
                for (int bj = 0; bj < 2; ++bj) { const int g = 8 * u.pn + 4 * bj + wc; const bool rp = (g % 3) == 2;
                    f32x4 x1 = acc[ai][bj][m][0] * sc, x2 = acc[ai][bj][m][1] * sc;
                    if (rp) { const f32x4 o1 = x1 * cv - x2 * sv, o2 = x1 * sv + x2 * cv; x1 = o1; x2 = o2; }
                    bf16_t* p = Q + (size_t)row * 768 + g * 32 + 4 * fq;
                    u32x2 w0, w1; w0.x = pk2(x1[0], x1[1]); w0.y = pk2(x1[2], x1[3]); w1.x = pk2(x2[0], x2[1]); w1.y = pk2(x2[2], x2[3]);
                    *(u32x2*)p = w0; *(u32x2*)(p + 16) = w1; } }
    }
};
template <bool BASE_BF16> struct EpiRes {
    static constexpr bool PERM = true;
    const void* base; bf16_t* out; const float* gate;
    __device__ __forceinline__ void operator()(const f32x4 (&acc)[2][2][4][2], const Unit& u, int wr, int wc, int fr, int fq) const {
        const int row0 = u.pm * BM + wr * 64 + fr; const int b = (u.pm * BM) / S;
        f32x4 gv[2][2];
#pragma unroll
        for (int bj = 0; bj < 2; ++bj)
#pragma unroll
            for (int n = 0; n < 2; ++n) gv[bj][n] = *(const f32x4*)(gate + (size_t)b * 6144 + u.pn * BM + bj * HALF + wc * 32 + 8 * fq + 4 * n);
#pragma unroll
        for (int ai = 0; ai < 2; ++ai)
#pragma unroll
            for (int m = 0; m < 4; ++m) { const size_t off = (size_t)(row0 + ai * HALF + m * 16) * D + u.pn * BM + wc * 32 + 8 * fq;
#pragma unroll
                for (int bj = 0; bj < 2; ++bj) { const size_t o = off + bj * HALF; f32x4 b0, b1;
                    if (BASE_BF16) { const u32x4 r = *(const u32x4*)((const bf16_t*)base + o);
                        b0 = (f32x4){__uint_as_float(r.x << 16), __uint_as_float(r.x & 0xffff0000u), __uint_as_float(r.y << 16), __uint_as_float(r.y & 0xffff0000u)};
                        b1 = (f32x4){__uint_as_float(r.z << 16), __uint_as_float(r.z & 0xffff0000u), __uint_as_float(r.w << 16), __uint_as_float(r.w & 0xffff0000u)}; }
                    else { b0 = *(const f32x4*)((const float*)base + o); b1 = *(const f32x4*)((const float*)base + o + 4); }
                    const f32x4 v0 = b0 + gv[bj][0] * acc[ai][bj][m][0], v1 = b1 + gv[bj][1] * acc[ai][bj][m][1];
                    u32x4 w; w.x = pk2(v0[0], v0[1]); w.y = pk2(v0[2], v0[3]); w.z = pk2(v1[0], v1[1]); w.w = pk2(v1[2], v1[3]);
                    *(u32x4*)(out + o) = w; } }
    }
};
struct EpiSwiglu {
    static constexpr bool PERM = true;
    bf16_t* H;
    __device__ __forceinline__ void operator()(const f32x4 (&acc)[2][2][4][2], const Unit& u, int wr, int wc, int fr, int fq) const {
        const int row0 = u.pm * BM + wr * 64 + fr, col0 = u.pn * HALF + wc * 32 + 8 * fq;
#pragma unroll
        for (int ai = 0; ai < 2; ++ai)
#pragma unroll
            for (int m = 0; m < 4; ++m) { float v[8];
#pragma unroll
                for (int n = 0; n < 2; ++n)
#pragma unroll
                    for (int j = 0; j < 4; ++j) { const float gt = acc[ai][0][m][n][j], up = acc[ai][1][m][n][j]; v[4 * n + j] = siluf_(gt) * up; }
                u32x4 w; w.x = pk2(v[0], v[1]); w.y = pk2(v[2], v[3]); w.z = pk2(v[4], v[5]); w.w = pk2(v[6], v[7]);
                *(u32x4*)(H + (size_t)(row0 + ai * HALF + m * 16) * FF + col0) = w; }
    }
};
}

struct Args { const void* in[32]; float* out; unsigned char* ws; int ph_lo, ph_hi; };

struct Ctx {
    LAS unsigned char* lds; int G, bid, wid;
    const __attribute__((address_space(4))) unsigned long long* in;
    float* out; unsigned char* ws;
};
#define INF(i) ((const float*)F.in[i])
#define F_x INF(0)
#define F_c INF(1)
#define F_pos ((const int*)F.in[2])
#define F_ada_w INF(3)
#define F_ada_b INF(4)
#define F_norm_mix INF(5)
#define F_norm_ffn INF(6)
#define F_w_in_even INF(7)
#define F_q_norm INF(8)
#define F_w_uq INF(9)
#define F_kv_norm INF(10)
#define F_w_ukv INF(11)
#define F_mu INF(12)
#define F_w0 INF(13)
#define F_w2 INF(14)
#define F_a0 INF(15)
#define F_a2 INF(16)
#define F_g2 INF(17)
#define F_k_k INF(18)
#define F_k_a INF(19)
#define F_r_k INF(20)
#define F_ln_w INF(21)
#define F_ln_b INF(22)
#define F_w_out_even INF(23)
#define F_w_in_odd INF(24)
#define F_lb_logits INF(25)
#define F_hg_norm INF(26)
#define F_w_out_odd INF(27)
#define F_w_gate INF(28)
#define F_w_up INF(29)
#define F_w_down INF(30)
#define F_final_norm INF(31)

__device__ __forceinline__ void tr_item(const float* W, int K, int N, bf16_t* WT, int ldt, int rowmode, const float* ksc, LAS float* scr, int item, int lane) {
    const int nblk = N / 32, kb = item / nblk, nb = item % nblk, k0 = 64 * kb, n0 = 32 * nb;
#pragma unroll 8
    for (int i = 0; i < 32; ++i) { const int kk = 2 * i + (lane >> 5); float v = W[(size_t)(k0 + kk) * N + n0 + (lane & 31)]; if (ksc) v *= ksc[k0 + kk]; scr[kk * 33 + (lane & 31)] = v; }
    asm volatile("s_waitcnt lgkmcnt(0)" ::: "memory");
    const int c = lane & 7;
#pragma unroll
    for (int j = 0; j < 4; ++j) { const int n = n0 + (lane >> 3) + 8 * j; const LAS float* s = scr + (8 * c) * 33 + (lane >> 3) + 8 * j;
        u32x4 o; o.x = pk2(s[0 * 33], s[1 * 33]); o.y = pk2(s[2 * 33], s[3 * 33]); o.z = pk2(s[4 * 33], s[5 * 33]); o.w = pk2(s[6 * 33], s[7 * 33]);
        int row = n; if (rowmode) row = (n >> 7) * 256 + (n & 127) + (rowmode == 2 ? 128 : 0);
        *(u32x4*)(WT + (size_t)row * ldt + k0 + 8 * c) = o; }
    asm volatile("s_waitcnt lgkmcnt(0)" ::: "memory");
}

__device__ __forceinline__ void p0_prologue(const Ctx& F) {
    float* mod = (float*)(F.ws + WS_MOD);
    for (int it = F.bid; it < 192; it += F.G) {
        const int l = it / 96, n0 = (it % 96) * 64;
        LAS float* cs = (LAS float*)F.lds;
        for (int e = (F.wid * 64 + lane_id_()); e < 32768; e += NTHREADS) { const int k = e >> 5, b = e & 31; cs[e] = siluf_(F_c[b * 1024 + k]); }
        __syncthreads();
        const int n = (F.wid * 64 + lane_id_()) & 63, kp = (F.wid * 64 + lane_id_()) >> 6;
        float acc[32];
#pragma unroll
        for (int b = 0; b < 32; ++b) acc[b] = 0.f;
        const float* wp = F_ada_w + ((size_t)l * 1024 + kp * 128) * 6144 + n0 + n;
        for (int k8 = 0; k8 < 128; k8 += 8) {
            float wv[8];
#pragma unroll
            for (int u = 0; u < 8; ++u) wv[u] = wp[(size_t)(k8 + u) * 6144];
#pragma unroll
            for (int u = 0; u < 8; ++u) { const float w = wv[u]; const LAS f32x4* cr = (const LAS f32x4*)(cs + (kp * 128 + k8 + u) * 32);
#pragma unroll
                for (int b4 = 0; b4 < 8; ++b4) { const f32x4 cv = cr[b4]; acc[4 * b4] += cv[0] * w; acc[4 * b4 + 1] += cv[1] * w; acc[4 * b4 + 2] += cv[2] * w; acc[4 * b4 + 3] += cv[3] * w; } }
        }
        __syncthreads();
        LAS float* red = (LAS float*)F.lds;
#pragma unroll
        for (int b = 0; b < 32; ++b) red[(kp * 32 + b) * 64 + n] = acc[b];
        __syncthreads();
#pragma unroll
        for (int i = 0; i < 4; ++i) { const int o = (F.wid * 64 + lane_id_()) + NTHREADS * i, b = o >> 6, nn = o & 63; float s = F_ada_b[l * 6144 + n0 + nn];
#pragma unroll
            for (int p = 0; p < 8; ++p) s += red[(p * 32 + b) * 64 + nn];
            mod[((size_t)l * 32 + b) * 6144 + n0 + nn] = s; }
        __syncthreads();
    }
    {
        LAS float* scr = (LAS float*)(F.lds + F.wid * 16384);
        const int gw = F.bid * NWAVES + F.wid, NGW = F.G * NWAVES;
        bf16_t* WinE = (bf16_t*)(F.ws + WS_WINE); bf16_t* Wuq = (bf16_t*)(F.ws + WS_WUQ); bf16_t* Wukv = (bf16_t*)(F.ws + WS_WUKV);
        bf16_t* WoutE = (bf16_t*)(F.ws + WS_WOUTE); bf16_t* WinO = (bf16_t*)(F.ws + WS_WINO); bf16_t* WoutO = (bf16_t*)(F.ws + WS_WOUTO);
        bf16_t* Wgu = (bf16_t*)(F.ws + WS_WGU); bf16_t* Wd = (bf16_t*)(F.ws + WS_WD);
        constexpr int I1 = 16 * 77, I2 = 6 * 24, I3 = 4 * 32, I4 = 16 * 32, I5 = 16 * 128, I6 = 16 * 32, I7 = 16 * 88, I9 = 44 * 32;
        constexpr int NIT = I1 + I2 + I3 + I4 + I5 + I6 + 4 * I7 + 2 * I9;
        for (int it = gw; it < NIT; it += NGW) {
            int r = it;
            if (r < I1) { tr_item(F_w_in_even, 1024, IN_EVEN, WinE, 1024, 0, nullptr, scr, r, lane_id_()); continue; } r -= I1;
            if (r < I2) { tr_item(F_w_uq, 384, 768, Wuq, 384, 0, F_q_norm, scr, r, lane_id_()); continue; } r -= I2;
            if (r < I3) { tr_item(F_w_ukv, 256, 1024, Wukv, 256, 0, F_kv_norm, scr, r, lane_id_()); continue; } r -= I3;
            if (r < I4) { tr_item(F_w_out_even, 1024, 1024, WoutE, 1024, 0, nullptr, scr, r, lane_id_()); continue; } r -= I4;
            if (r < I5) { tr_item(F_w_in_odd, 1024, 4096, WinO, 1024, 0, nullptr, scr, r, lane_id_()); continue; } r -= I5;
            if (r < I6) { tr_item(F_w_out_odd, 1024, 1024, WoutO, 1024, 0, nullptr, scr, r, lane_id_()); continue; } r -= I6;
            if (r < 4 * I7) { const int q = r / I7, l = q >> 1, up = q & 1; r -= q * I7;
                tr_item((up ? F_w_up : F_w_gate) + (size_t)l * 1024 * FF, 1024, FF, Wgu + (size_t)l * 5632 * 1024, 1024, 1 + up, nullptr, scr, r, lane_id_()); continue; } r -= 4 * I7;
            { const int l = r / I9; r -= l * I9; tr_item(F_w_down + (size_t)l * FF * 1024, FF, 1024, Wd + (size_t)l * 1024 * FF, FF, 0, nullptr, scr, r, lane_id_()); }
        }
    }
    {
        const size_t gt = (size_t)F.bid * NTHREADS + (F.wid * 64 + lane_id_()), NGT = (size_t)F.G * NTHREADS;
        bf16_t* WinE = (bf16_t*)(F.ws + WS_WINE); bf16_t* Wl = (bf16_t*)(F.ws + WS_WLORA); float* lb = (float*)(F.ws + WS_LB);
        for (size_t e = gt; e < (size_t)96 * 1024; e += NGT) WinE[(size_t)IN_EVEN * 1024 + e] = 0;
        for (size_t e = gt; e < (size_t)1536 * 256; e += NGT) { const int n = (int)(e >> 8), k = (int)(e & 255); float v = 0.f;
            if (n < 512) { if (k < 64) v = F_w2[k * 512 + n]; }
            else if (n < 1024) { if (k >= 64 && k < 128) v = F_a2[(k - 64) * 512 + (n - 512)]; }
            else { if (k >= 128) v = F_g2[(k - 128) * 512 + (n - 1024)]; }
            Wl[e] = f2bf(v); }
        for (size_t e = gt; e < 1024; e += NGT) lb[e] = sigmoidf_(F_lb_logits[1024 + e] - F_lb_logits[e]);
    }
}

__device__ __forceinline__ void norm_mod_phase(const Ctx& F, const float* xin, const float* gain, const float* shift, const float* scale) {
    const int ln = lane_id_();
    bf16_t* hb = (bf16_t*)(F.ws + WS_HB);
    const int gw = F.bid * NWAVES + F.wid, NGW = F.G * NWAVES;
    for (int ch = gw; ch < T / 32; ch += NGW) {
        const int row0 = ch * 32, b = row0 / S;
        f32x4 ga[4], sh[4];
#pragma unroll
        for (int j = 0; j < 4; ++j) { const int c = 4 * ln + 256 * j; const f32x4 g = *(const f32x4*)(gain + c), sc = *(const f32x4*)(scale + (size_t)b * 6144 + c);
            ga[j] = g * (sc + 1.0f); sh[j] = *(const f32x4*)(shift + (size_t)b * 6144 + c); }
        for (int r = 0; r < 32; r += 4) {
            f32x4 v[4][4]; float s[4];
#pragma unroll
            for (int u = 0; u < 4; ++u) { const float* xr = xin + (size_t)(row0 + r + u) * D; s[u] = 0.f;
#pragma unroll
                for (int j = 0; j < 4; ++j) v[u][j] = *(const f32x4*)(xr + 4 * ln + 256 * j); }
#pragma unroll
            for (int u = 0; u < 4; ++u) {
#pragma unroll
                for (int j = 0; j < 4; ++j) s[u] += (v[u][j][0] * v[u][j][0] + v[u][j][1] * v[u][j][1]) + (v[u][j][2] * v[u][j][2] + v[u][j][3] * v[u][j][3]);
                s[u] = wave_sum_fast(s[u]); }
#pragma unroll
            for (int u = 0; u < 4; ++u) { const float rstd = 1.0f / sqrtf(s[u] * (1.0f / D) + 1e-6f);
#pragma unroll
                for (int j = 0; j < 4; ++j) { const f32x4 o = v[u][j] * rstd * ga[j] + sh[j]; u32x2 w; w.x = pk2(o[0], o[1]); w.y = pk2(o[2], o[3]);
                    *(u32x2*)(hb + (size_t)(row0 + r + u) * D + 4 * ln + 256 * j) = w; } }
        }
    }
}

__device__ __forceinline__ void unpack8(const u32x4 r, float (&f)[8]) {
    f[0] = __uint_as_float(r.x << 16); f[1] = __uint_as_float(r.x & 0xffff0000u); f[2] = __uint_as_float(r.y << 16); f[3] = __uint_as_float(r.y & 0xffff0000u);
    f[4] = __uint_as_float(r.z << 16); f[5] = __uint_as_float(r.z & 0xffff0000u); f[6] = __uint_as_float(r.w << 16); f[7] = __uint_as_float(r.w & 0xffff0000u); }
__device__ __forceinline__ void norm_mod_bf16_phase(const Ctx& F, const bf16_t* xin, const float* gain, const float* shift, const float* scale) {
    const int ln = lane_id_();
    bf16_t* hb = (bf16_t*)(F.ws + WS_HB);
    const int gw = F.bid * NWAVES + F.wid, NGW = F.G * NWAVES;
    for (int ch = gw; ch < T / 32; ch += NGW) {
        const int row0 = ch * 32, b = row0 / S;
        float ga[2][8], sh[2][8];
#pragma unroll
        for (int j = 0; j < 2; ++j)
#pragma unroll
            for (int h = 0; h < 2; ++h) { const int c = 8 * ln + 512 * j + 4 * h; const f32x4 g = *(const f32x4*)(gain + c), sc = *(const f32x4*)(scale + (size_t)b * 6144 + c), s4 = *(const f32x4*)(shift + (size_t)b * 6144 + c);
#pragma unroll
                for (int e = 0; e < 4; ++e) { ga[j][4 * h + e] = g[e] * (sc[e] + 1.0f); sh[j][4 * h + e] = s4[e]; } }
        for (int r = 0; r < 32; r += 4) {
            u32x4 raw[4][2]; float s[4];
#pragma unroll
            for (int u = 0; u < 4; ++u)
#pragma unroll
                for (int j = 0; j < 2; ++j) raw[u][j] = *(const u32x4*)(xin + (size_t)(row0 + r + u) * D + 8 * ln + 512 * j);
#pragma unroll
            for (int u = 0; u < 4; ++u) { s[u] = 0.f;
#pragma unroll
                for (int j = 0; j < 2; ++j) { float f[8]; unpack8(raw[u][j], f);
#pragma unroll
                    for (int e = 0; e < 8; ++e) s[u] += f[e] * f[e]; }
                s[u] = wave_sum_fast(s[u]); }
#pragma unroll
            for (int u = 0; u < 4; ++u) { const float rstd = 1.0f / sqrtf(s[u] * (1.0f / D) + 1e-6f);
#pragma unroll
                for (int j = 0; j < 2; ++j) { float f[8]; unpack8(raw[u][j], f); float o[8];
#pragma unroll
                    for (int e = 0; e < 8; ++e) o[e] = f[e] * rstd * ga[j][e] + sh[j][e];
                    u32x4 w; w.x = pk2(o[0], o[1]); w.y = pk2(o[2], o[3]); w.z = pk2(o[4], o[5]); w.w = pk2(o[6], o[7]);
                    *(u32x4*)(hb + (size_t)(row0 + r + u) * D + 8 * ln + 512 * j) = w; } }
        }
    }
}

__device__ __forceinline__ void prep_even_phase(const Ctx& F) {
    const bf16_t* proj = (const bf16_t*)(F.ws + WS_BIG);
    float* stats = (float*)(F.ws + WS_STATS); float* cs = (float*)(F.ws + WS_CS);
    bf16_t* KR = (bf16_t*)(F.ws + WS_KR); bf16_t* AP = (bf16_t*)(F.ws + WS_AP);
    const int gw = F.bid * NWAVES + F.wid, NGW = F.G * NWAVES, lane = lane_id_();
    const int l32 = lane & 31;
    float mu8[8];
    { const f32x4 m0 = *(const f32x4*)(F_mu + 1536 + 8 * l32), m1 = *(const f32x4*)(F_mu + 1536 + 8 * l32 + 4); mu8[0] = m0[0]; mu8[1] = m0[1]; mu8[2] = m0[2]; mu8[3] = m0[3]; mu8[4] = m1[0]; mu8[5] = m1[1]; mu8[6] = m1[2]; mu8[7] = m1[3]; }
    const float inv = __builtin_amdgcn_exp2f(-13.287712379549449f * ((float)(lane & 15) * (1.0f / 16.0f)));
    const u32x4 z4 = {0u, 0u, 0u, 0u};
    for (int ch = gw; ch < T / 4; ch += NGW) {
        u32x4 rq[4], rkv[4], rc[4], rpv[4]; bf16_t kr[4][2]; int ps[4];
#pragma unroll
        for (int u = 0; u < 4; ++u) {
            const int row = 4 * ch + u, s = row % S;
            const bf16_t* p = proj + (size_t)row * IN_EVEN_P;
            rq[u] = lane < 48 ? *(const u32x4*)(p + 8 * lane) : z4;
            rkv[u] = *(const u32x4*)(p + 384 + 8 * l32);
            rc[u] = *(const u32x4*)(p + RW_OFF + 1536 + 8 * l32);
            rpv[u] = s > 0 ? *(const u32x4*)(p + RW_OFF + 1536 + 8 * l32 - IN_EVEN_P) : z4;
            kr[u][0] = p[640 + (lane & 15)]; kr[u][1] = p[656 + (lane & 15)];
            ps[u] = F_pos[row];
        }
#pragma unroll
        for (int u = 0; u < 4; ++u) {
            const int row = 4 * ch + u, b = row / S, s = row % S;
            float f[8]; float sq = 0.f, skv = 0.f;
            unpack8(rq[u], f);
#pragma unroll
            for (int e = 0; e < 8; ++e) sq += f[e] * f[e];
            unpack8(rkv[u], f);
#pragma unroll
            for (int e = 0; e < 8; ++e) skv += f[e] * f[e];
            sq = wave_sum_fast(sq); skv = wave_sum_fast(skv) * 0.5f;
            if (lane == 0) { stats[2 * row] = 1.0f / sqrtf(sq * (1.0f / 384.f) + 1e-6f); stats[2 * row + 1] = 1.0f / sqrtf(skv * (1.0f / 256.f) + 1e-6f); }
            if (lane < 16) {
                const float ang = (float)ps[u] * inv;
                double rev = (double)ang * 0.15915494309189535; rev -= floor(rev);
                const float cv = __builtin_amdgcn_cosf((float)rev), sv = __builtin_amdgcn_sinf((float)rev);
                cs[(size_t)row * 32 + lane] = cv; cs[(size_t)row * 32 + 16 + lane] = sv;
                const float x1 = bf2f(kr[u][0]), x2 = bf2f(kr[u][1]);
                const bf16_t o1 = f2bf(x1 * cv - x2 * sv), o2 = f2bf(x1 * sv + x2 * cv);
                { bf16_t* kp = KR + (size_t)row * 32; kp[lane] = o1; kp[16 + lane] = o2; }
            }
            if (lane < 32) {
                float cu[8], pv[8], o[8]; unpack8(rc[u], cu); unpack8(rpv[u], pv);
#pragma unroll
                for (int e = 0; e < 8; ++e) { float v = cu[e] + (pv[e] - cu[e]) * mu8[e]; if (lane < 8) v = tanhf(v); else if (lane >= 16) v = sigmoidf_(v); o[e] = v; }
                *(u32x4*)(AP + (size_t)row * 256 + 8 * lane) = (u32x4){pk2(o[0], o[1]), pk2(o[2], o[3]), pk2(o[4], o[5]), pk2(o[6], o[7])};
            }
        }
    }
}

__device__ __forceinline__ int crow(int r, int hi) { return (r & 3) + 8 * (r >> 2) + 4 * hi; }
constexpr int KP = 208, VP = 136;
__device__ __forceinline__ void attn_bh(const Ctx& F, int b, int h) {
    const bf16_t* Q = (const bf16_t*)(F.ws + WS_Q);
    const bf16_t* Kh = (const bf16_t*)(F.ws + WS_KH) + (size_t)(b * 8 + h) * S * 64;
    const bf16_t* Krp = (const bf16_t*)(F.ws + WS_KR) + (size_t)b * S * 32;
    const bf16_t* Vh = (const bf16_t*)(F.ws + WS_VH) + (size_t)(b * 8 + h) * S * 64;
    bf16_t* Y = (bf16_t*)(F.ws + WS_HB);
    LAS unsigned char* Kl = F.lds; LAS unsigned char* Vl = F.lds + 64 * KP;
    const int tid = (F.wid * 64 + lane_id_()), lane = lane_id_(), w = F.wid, q31 = lane & 31, hi = lane >> 5;
    for (int qb = 0; qb < 8; ++qb) {
        const int q0 = qb * 256, NT = 4 * (qb + 1), qrow = q0 + 32 * w + q31, wlast = q0 + 32 * w + 31;
        bf16x8 qf[6];
#pragma unroll
        for (int d0 = 0; d0 < 6; ++d0) qf[d0] = *(const bf16x8*)(Q + (size_t)(b * S + qrow) * 768 + h * 96 + 16 * d0 + 8 * hi);
        f32x16 o0, o1;
#pragma unroll
        for (int r = 0; r < 16; ++r) { o0[r] = 0.f; o1[r] = 0.f; }
        float mrun = -INFINITY, lrun = 0.f;
        u32x4 kr0, kr1, vr;
        kr0 = *(const u32x4*)(Kh + (size_t)tid * 8); kr1 = (u32x4){0u, 0u, 0u, 0u}; if (tid < 256) kr1 = *(const u32x4*)(Krp + (size_t)tid * 8); vr = *(const u32x4*)(Vh + (size_t)tid * 8);
        for (int t = 0; t < NT; ++t) {
            __syncthreads();
            *(LAS u32x4*)(Kl + (tid >> 3) * KP + (tid & 7) * 16) = kr0;
            if (tid < 256) *(LAS u32x4*)(Kl + (tid >> 2) * KP + 128 + (tid & 3) * 16) = kr1;
            { const int kv = tid >> 3, dc = tid & 7;
#pragma unroll
              for (int j = 0; j < 4; ++j) { const unsigned wv = vr[j];
                  *(LAS bf16_t*)(Vl + (8 * dc + 2 * j) * VP + kv * 2) = (bf16_t)(wv & 0xffffu); *(LAS bf16_t*)(Vl + (8 * dc + 2 * j + 1) * VP + kv * 2) = (bf16_t)(wv >> 16); } }
            __syncthreads();
            if (t + 1 < NT) { const bf16_t* kn = Kh + (size_t)(t + 1) * 64 * 64; const bf16_t* krn = Krp + (size_t)(t + 1) * 64 * 32; const bf16_t* vn = Vh + (size_t)(t + 1) * 64 * 64;
                kr0 = *(const u32x4*)(kn + (size_t)tid * 8); if (tid < 256) kr1 = *(const u32x4*)(krn + (size_t)tid * 8); vr = *(const u32x4*)(vn + (size_t)tid * 8); }
            const int kv0 = 64 * t;
            if (kv0 <= wlast) {
                f32x16 p0, p1;
#pragma unroll
                for (int r = 0; r < 16; ++r) { p0[r] = 0.f; p1[r] = 0.f; }
#pragma unroll
                for (int d0 = 0; d0 < 6; ++d0) {
                    const bf16x8 a0 = *(const LAS bf16x8*)(Kl + q31 * KP + (16 * d0 + 8 * hi) * 2);
                    const bf16x8 a1 = *(const LAS bf16x8*)(Kl + (32 + q31) * KP + (16 * d0 + 8 * hi) * 2);
                    p0 = __builtin_amdgcn_mfma_f32_32x32x16_bf16(a0, qf[d0], p0, 0, 0, 0);
                    p1 = __builtin_amdgcn_mfma_f32_32x32x16_bf16(a1, qf[d0], p1, 0, 0, 0);
                }
                if (kv0 + 63 > q0 + 32 * w) {
#pragma unroll
                    for (int r = 0; r < 16; ++r) { const int kv = kv0 + crow(r, hi); if (kv > qrow) p0[r] = -INFINITY; if (kv + 32 > qrow) p1[r] = -INFINITY; }
                }
                float mt = p0[0];
#pragma unroll
                for (int r = 1; r < 16; ++r) mt = fmaxf(mt, p0[r]);
#pragma unroll
                for (int r = 0; r < 16; ++r) mt = fmaxf(mt, p1[r]);
                mt = fmaxf(mt, __shfl_xor(mt, 32));
                if (__any(mt > mrun + 8.0f)) {
                    const float mnew = fmaxf(mrun, mt), alpha = __builtin_amdgcn_exp2f(mrun - mnew);
                    mrun = mnew; lrun *= alpha;
#pragma unroll
                    for (int r = 0; r < 16; ++r) { o0[r] *= alpha; o1[r] *= alpha; }
                }
                float ls = 0.f;
#pragma unroll
                for (int r = 0; r < 16; ++r) { p0[r] = __builtin_amdgcn_exp2f(p0[r] - mrun); p1[r] = __builtin_amdgcn_exp2f(p1[r] - mrun); ls += p0[r] + p1[r]; }
                lrun += ls;
                bf16x8 pk[4];
#pragma unroll
                for (int c2 = 0; c2 < 2; ++c2) {
                    u32x4 a, bq;
#pragma unroll
                    for (int j = 0; j < 4; ++j) { a[j] = pk2(p0[8 * c2 + 2 * j], p0[8 * c2 + 2 * j + 1]); bq[j] = pk2(p1[8 * c2 + 2 * j], p1[8 * c2 + 2 * j + 1]); }
                    pk[c2] = __builtin_bit_cast(bf16x8, a); pk[2 + c2] = __builtin_bit_cast(bf16x8, bq);
                }
#pragma unroll
                for (int hc = 0; hc < 4; ++hc) {
                    const int kvb = 16 * hc + 4 * hi;
                    const u32x2 l0 = *(const LAS u32x2*)(Vl + q31 * VP + kvb * 2), h0 = *(const LAS u32x2*)(Vl + q31 * VP + (kvb + 8) * 2);
                    const u32x2 l1 = *(const LAS u32x2*)(Vl + (32 + q31) * VP + kvb * 2), h1 = *(const LAS u32x2*)(Vl + (32 + q31) * VP + (kvb + 8) * 2);
                    const u32x4 va = {l0.x, l0.y, h0.x, h0.y}, vb = {l1.x, l1.y, h1.x, h1.y};
                    o0 = __builtin_amdgcn_mfma_f32_32x32x16_bf16(__builtin_bit_cast(bf16x8, va), pk[hc], o0, 0, 0, 0);
                    o1 = __builtin_amdgcn_mfma_f32_32x32x16_bf16(__builtin_bit_cast(bf16x8, vb), pk[hc], o1, 0, 0, 0);
                }
            }
        }
        lrun += __shfl_xor(lrun, 32);
        const float inv = 1.0f / lrun;
        bf16_t* yp = Y + (size_t)(b * S + qrow) * D + h * 64;
#pragma unroll
        for (int g = 0; g < 4; ++g) {
            u32x2 w0, w1; w0.x = pk2(o0[4 * g] * inv, o0[4 * g + 1] * inv); w0.y = pk2(o0[4 * g + 2] * inv, o0[4 * g + 3] * inv);
            w1.x = pk2(o1[4 * g] * inv, o1[4 * g + 1] * inv); w1.y = pk2(o1[4 * g + 2] * inv, o1[4 * g + 3] * inv);
            *(u32x2*)(yp + 8 * g + 4 * hi) = w0; *(u32x2*)(yp + 32 + 8 * g + 4 * hi) = w1;
        }
    }
    __syncthreads();
}

constexpr int RC = 32;
__device__ __forceinline__ void rwkv_bh(const Ctx& F, int b, int h) {
    const bf16_t* proj = (const bf16_t*)(F.ws + WS_BIG); const bf16_t* LO = (const bf16_t*)(F.ws + WS_LORA);
    bf16_t* Y = (bf16_t*)(F.ws + WS_HB);
    LAS float* Wl = (LAS float*)F.lds; LAS float* KKl = Wl + RC * 64; LAS float* KAl = KKl + RC * 64; LAS float* Kl = KAl + RC * 64; LAS float* WRl = Kl + RC * 64; LAS float* Vl = WRl + RC * 64; LAS float* Yl = Vl + RC * 64;
    LAS float* C1l = Yl + RC * 128; LAS float* C2l = C1l + RC; LAS float* BOl = C2l + RC;
    const int lane = lane_id_(), w = F.wid, col = h * 64 + lane;
    const float mu_r = F_mu[col], mu_k = F_mu[512 + col], mu_v = F_mu[1024 + col], w0 = F_w0[col], a0 = F_a0[col], k_k = F_k_k[col], k_a = F_k_a[col], r_k = F_r_k[col], ln_w = F_ln_w[col], ln_b = F_ln_b[col];
    const int rp = lane >> 4, kq = lane & 15;
    const bool b0 = (kq & 1) != 0, b1 = (kq & 2) != 0;
    f32x2 sA[2] = {(f32x2){0.f, 0.f}, (f32x2){0.f, 0.f}}, sB[2] = {(f32x2){0.f, 0.f}, (f32x2){0.f, 0.f}};
    bf16_t raw[RC / 8][8];
#define RW_LOAD(CH) do { _Pragma("unroll") for (int i = 0; i < RC / 8; ++i) { const int t_ = (CH) * RC + w + 8 * i; const size_t row_ = (size_t)b * S + t_; \
        const bf16_t* p_ = proj + row_ * IN_EVEN_P + RW_OFF + col; raw[i][0] = p_[0]; raw[i][1] = p_[512]; raw[i][2] = p_[1024]; \
        if (t_ > 0) { raw[i][3] = p_[-IN_EVEN_P]; raw[i][4] = p_[512 - IN_EVEN_P]; raw[i][5] = p_[1024 - IN_EVEN_P]; } else { raw[i][3] = 0; raw[i][4] = 0; raw[i][5] = 0; } \
        raw[i][6] = LO[row_ * 1536 + col]; raw[i][7] = LO[row_ * 1536 + 512 + col]; } } while (0)
    RW_LOAD(0);
    for (int ch = 0; ch < S / RC; ++ch) {
        const int t0 = ch * RC;
#pragma unroll
        for (int i = 0; i < RC / 8; ++i) {
            const int tl = w + 8 * i;
            float r = bf2f(raw[i][0]), k = bf2f(raw[i][1]), v = bf2f(raw[i][2]);
            r += (bf2f(raw[i][3]) - r) * mu_r; k += (bf2f(raw[i][4]) - k) * mu_k; v += (bf2f(raw[i][5]) - v) * mu_v;
            const float dec = __expf(-0.6065306597126334f * sigmoidf_(w0 + bf2f(raw[i][6])));
            const float a = sigmoidf_(a0 + bf2f(raw[i][7]));
            float kk = k * k_k;
            const float km = k * (1.0f + (a - 1.0f) * k_a);
            const float s_n = wave_sum_fast(kk * kk), s_b = wave_sum_fast(r * km * r_k), s_2 = wave_sum_fast(km * r);
            kk = kk / fmaxf(sqrtf(s_n), 1e-12f);
            const float ka = kk * a;
            const float s_1 = wave_sum_fast(ka * r);
            Wl[tl * 64 + lane] = dec; KKl[tl * 64 + lane] = kk; KAl[tl * 64 + lane] = ka; Kl[tl * 64 + lane] = km; WRl[tl * 64 + lane] = dec * r; Vl[tl * 64 + lane] = v;
            if (lane == 0) { C1l[tl] = s_1; C2l[tl] = s_2; BOl[tl] = s_b; }
        }
        if (ch + 1 < S / RC) RW_LOAD(ch + 1);
        bf16_t gq[RC / 8];
#pragma unroll
        for (int i = 0; i < RC / 8; ++i) gq[i] = LO[((size_t)b * S + t0 + w + 8 * i) * 1536 + 1024 + col];
        __syncthreads();
        {
            f32x4 w4 = *(const LAS f32x4*)(Wl + 4 * kq), kk4 = *(const LAS f32x4*)(KKl + 4 * kq), ka4 = *(const LAS f32x4*)(KAl + 4 * kq), k4 = *(const LAS f32x4*)(Kl + 4 * kq), wr4 = *(const LAS f32x4*)(WRl + 4 * kq);
            f32x2 v2 = *(const LAS f32x2*)(Vl + 8 * w + 2 * rp);
#pragma unroll 2
            for (int tl = 0; tl < RC; ++tl) {
                const int tn = (tl + 1 < RC) ? tl + 1 : tl;
                const f32x4 w4n = *(const LAS f32x4*)(Wl + tn * 64 + 4 * kq), kk4n = *(const LAS f32x4*)(KKl + tn * 64 + 4 * kq), ka4n = *(const LAS f32x4*)(KAl + tn * 64 + 4 * kq),
                            k4n = *(const LAS f32x4*)(Kl + tn * 64 + 4 * kq), wr4n = *(const LAS f32x4*)(WRl + tn * 64 + 4 * kq);
                const f32x2 v2n = *(const LAS f32x2*)(Vl + tn * 64 + 8 * w + 2 * rp);
                const f32x2 kkA = {kk4[0], kk4[1]}, kkB = {kk4[2], kk4[3]}, wrA = {wr4[0], wr4[1]}, wrB = {wr4[2], wr4[3]};
                const f32x2 d0 = sA[0] * kkA + sB[0] * kkB, d1 = sA[1] * kkA + sB[1] * kkB, d2 = sA[0] * wrA + sB[0] * wrB, d3 = sA[1] * wrA + sB[1] * wrB;
                const float V0 = d0[0] + d0[1], V1 = d1[0] + d1[1], V2 = d2[0] + d2[1], V3 = d3[0] + d3[1];
                const float A = (b0 ? V1 : V0) + dpp_f<0xB1>(b0 ? V0 : V1);
                const float Bq = (b0 ? V3 : V2) + dpp_f<0xB1>(b0 ? V2 : V3);
                float Cc = (b1 ? Bq : A) + dpp_f<0x4E>(b1 ? A : Bq);
                Cc += dpp_f<0x124>(Cc);
                Cc += dpp_f<0x128>(Cc);
                const float sa0 = -dpp_f<0x00>(Cc), sa1 = -dpp_f<0x55>(Cc);
                { const f32x2 wA = {w4[0], w4[1]}, wB = {w4[2], w4[3]}, kaA = {ka4[0], ka4[1]}, kaB = {ka4[2], ka4[3]}, kA = {k4[0], k4[1]}, kB = {k4[2], k4[3]};
                  sA[0] = sA[0] * wA + kaA * sa0 + kA * v2[0]; sB[0] = sB[0] * wB + kaB * sa0 + kB * v2[0];
                  sA[1] = sA[1] * wA + kaA * sa1 + kA * v2[1]; sB[1] = sB[1] * wB + kaB * sa1 + kB * v2[1]; }
                Yl[tl * 128 + (4 * w + rp) * 4 + (kq & 3)] = Cc;
                w4 = w4n; kk4 = kk4n; ka4 = ka4n; k4 = k4n; wr4 = wr4n; v2 = v2n;
            }
        }
        __syncthreads();
#pragma unroll
        for (int i = 0; i < RC / 8; ++i) {
            const int tl = w + 8 * i, t = t0 + tl; const size_t row = (size_t)b * S + t;
            const float y = Yl[tl * 128 + (lane >> 1) * 4 + 2 + (lane & 1)] - Yl[tl * 128 + (lane >> 1) * 4 + (lane & 1)] * C1l[tl] + Vl[tl * 64 + lane] * C2l[tl];
            const float s1 = wave_sum_fast(y), s2 = wave_sum_fast(y * y);
            const float mean = s1 * (1.0f / 64.f), var = fmaxf(s2 * (1.0f / 64.f) - mean * mean, 0.f);
            const float yn = (y - mean) * (1.0f / sqrtf(var + 64e-5f)) * ln_w + ln_b;
            const float bonus = BOl[tl] * Vl[tl * 64 + lane];
            Y[row * D + 512 + col] = f2bf((yn + bonus) * bf2f(gq[i]));
        }
        __syncthreads();
    }
#undef RW_LOAD
}


constexpr int RX_QT = 0, RX_WYT = 4096, RX_NGT = 6144, RX_HT = 14336, RX_VT = 18432, RX_CC = 22528, RX_BON = 22784, RX_BYTES = 23040;
constexpr int RG = 4;
constexpr int RA_ZLO = 0, RA_DT = 4608, RA_ZHI = 9728, RA_ELO = 14336, RA_EHI = 18944, RA_AT = 23552, RA_M2 = 28672, RA_N1T = 31232, RA_CC = 33792, RA_BYTES = 34048;
constexpr int RB_SB = 0, RB_YL = 9216;
__device__ __forceinline__ unsigned launder_(unsigned x) { asm volatile("" : "+v"(x)); return x; }
__device__ __forceinline__ bf16x8 lds16(const LAS unsigned char* p) { return *(const LAS bf16x8*)p; }
__device__ __forceinline__ bf16x8 glb16(const unsigned char* p) { return *(const bf16x8*)p; }
#define MFMA16(a, b, c) __builtin_amdgcn_mfma_f32_16x16x32_bf16((a), (b), (c), 0, 0, 0)

__device__ __forceinline__ void rwkv_phaseA(const Ctx& F, LAS unsigned char* W, unsigned char* X, int b, int h, int c) {
    const bf16_t* proj = (const bf16_t*)(F.ws + WS_BIG); const bf16_t* LO = (const bf16_t*)(F.ws + WS_LORA);
    const int lane = lane_id_(), i = lane & 15, g = lane >> 4, col = h * 64 + lane;
    const float mu_r = F_mu[col], mu_k = F_mu[512 + col], mu_v = F_mu[1024 + col], w0 = F_w0[col], a0 = F_a0[col], k_k = F_k_k[col], k_a = F_k_a[col], r_k = F_r_k[col];
    float Bc = 0.f, cprev = 1.f;
    {
        const unsigned ul0 = (unsigned)lane;
        const size_t row0 = (size_t)b * S + c * 32;
        const bf16_t* pb = proj + row0 * IN_EVEN_P + RW_OFF + h * 64; const bf16_t* lb = LO + row0 * 1536 + h * 64;
        float pr_ = 0.f, pk_ = 0.f, pv_ = 0.f;
        if (c > 0) { const bf16_t* pp = pb - IN_EVEN_P; pr_ = bf2f(pp[ul0]); pk_ = bf2f(pp[512 + ul0]); pv_ = bf2f(pp[1024 + ul0]); }
        bf16_t cur[8][5], nxt[8][5];
#define RW_LD8(dst, t8_) do { const unsigned ul = launder_(ul0); _Pragma("unroll") for (int tt = 0; tt < 8; ++tt) { const bf16_t* p = pb + (size_t)(8 * (t8_) + tt) * IN_EVEN_P; const bf16_t* lo = lb + (size_t)(8 * (t8_) + tt) * 1536; \
            dst[tt][0] = p[ul]; dst[tt][1] = p[512 + ul]; dst[tt][2] = p[1024 + ul]; dst[tt][3] = lo[ul]; dst[tt][4] = lo[512 + ul]; } } while (0)
        RW_LD8(cur, 0);
#pragma unroll 1
        for (int t8 = 0; t8 < 4; ++t8) {
            const unsigned ulane = launder_(ul0);
            { const int tn = t8 < 3 ? t8 + 1 : 3; RW_LD8(nxt, tn); }
            unsigned at8[4], dt8[4], vt8[4];
#pragma unroll
            for (int tt = 0; tt < 8; ++tt) {
                const int t = 8 * t8 + tt;
                const float r0 = bf2f(cur[tt][0]), k0 = bf2f(cur[tt][1]), v0 = bf2f(cur[tt][2]);
                const float r = r0 + (pr_ - r0) * mu_r, k = k0 + (pk_ - k0) * mu_k, v = v0 + (pv_ - v0) * mu_v; pr_ = r0; pk_ = k0; pv_ = v0;
                Bc += -0.6065306597126334f * sigmoidf_(w0 + bf2f(cur[tt][3]));
                const float ct = __expf(Bc), ci = __expf(-Bc);
                const float a = sigmoidf_(a0 + bf2f(cur[tt][4]));
                float kk = k * k_k; const float km = k * (1.0f + (a - 1.0f) * k_a);
                const float s_n = wave_sum_fast(kk * kk), s_b = wave_sum_fast(r * km * r_k);
                kk = kk * __builtin_amdgcn_rsqf(fmaxf(s_n, 1e-24f));
                const float Ak = kk * a * ci, Kc = km * ci, Dk = kk * cprev, Rk = r * ct; cprev = ct;
                const bf16_t ab = f2bf(Ak), db = f2bf(Dk), vb = f2bf(v);
                *(LAS bf16_t*)(W + RA_ZLO + t * 144 + 2 * lane) = ab; *(LAS bf16_t*)(W + RA_ZHI + t * 144 + 2 * lane) = f2bf(Kc);
                *(LAS bf16_t*)(W + RA_ELO + t * 144 + 2 * lane) = db; *(LAS bf16_t*)(W + RA_EHI + t * 144 + 2 * lane) = f2bf(Rk);
                if (tt & 1) { at8[tt >> 1] |= (unsigned)ab << 16; dt8[tt >> 1] |= (unsigned)db << 16; vt8[tt >> 1] |= (unsigned)vb << 16; } else { at8[tt >> 1] = ab; dt8[tt >> 1] = db; vt8[tt >> 1] = vb; }
                if (lane == 0) *(float*)(X + RX_BON + 4 * t) = s_b;
            }
            *(LAS u32x4*)(W + RA_AT + lane * 80 + 16 * t8) = (u32x4){at8[0], at8[1], at8[2], at8[3]};
            *(LAS u32x4*)(W + RA_DT + lane * 80 + 16 * t8) = (u32x4){dt8[0], dt8[1], dt8[2], dt8[3]};
            *(u32x4*)(X + RX_VT + 16 * t8 + ulane * 64u) = (u32x4){vt8[0], vt8[1], vt8[2], vt8[3]};
#pragma unroll
            for (int tt = 0; tt < 8; ++tt)
#pragma unroll
                for (int q = 0; q < 5; ++q) cur[tt][q] = nxt[tt][q];
        }
#undef RW_LD8
    }
    *(LAS float*)(W + RA_CC + 4 * lane) = cprev; *(float*)(X + RX_CC + (unsigned)(4 * lane)) = cprev;
    asm volatile("s_waitcnt lgkmcnt(0)" ::: "memory");
    {
        bf16x8 bfr[2][4];
#pragma unroll
        for (int ks = 0; ks < 2; ++ks)
#pragma unroll
            for (int q = 0; q < 4; ++q) bfr[ks][q] = lds16(W + (q < 2 ? RA_ELO : RA_EHI) + (16 * (q & 1) + i) * 144 + (32 * ks + 8 * g) * 2);
#pragma unroll 1
        for (int mt = 0; mt < 4; ++mt) {
            const LAS unsigned char* arow = W + (mt < 2 ? RA_ZLO : RA_ZHI) + (16 * (mt & 1) + i) * 144 + 16 * g;
            const bf16x8 a0 = lds16(arow), a1 = lds16(arow + 64);
            f32x4 Tt[4];
#pragma unroll
            for (int nt = 0; nt < 4; ++nt) { Tt[nt] = MFMA16(a0, bfr[0][nt], ((f32x4){0.f, 0.f, 0.f, 0.f})); Tt[nt] = MFMA16(a1, bfr[1][nt], Tt[nt]); }
            const int s0 = 16 * (mt & 1) + 4 * g;
#pragma unroll
            for (int nt = 0; nt < 2; ++nt) {
                const int t = 16 * nt + i; f32x4 lo = Tt[nt], hi = Tt[2 + nt];
#pragma unroll
                for (int r = 0; r < 4; ++r) { if (!(s0 + r < t)) lo[r] = 0.f; if (!(s0 + r <= t)) hi[r] = 0.f; }
                if (mt < 2) {
#pragma unroll
                    for (int r = 0; r < 4; ++r) *(LAS float*)(W + RA_ZLO + ((s0 + r) * 32 + t) * 4) = lo[r];
                    *(LAS u32x2*)(W + RA_N1T + t * 80 + s0 * 2) = (u32x2){pk2(hi[0], hi[1]), pk2(hi[2], hi[3])};
                } else {
#pragma unroll
                    for (int r = 0; r < 4; ++r) { *(LAS bf16_t*)(W + RA_M2 + (s0 + r) * 80 + 2 * t) = f2bf(lo[r]);
                                                  *(LAS float*)(W + RA_ELO + ((s0 + r) * 32 + t) * 4) = hi[r]; }
                }
            }
        }
    }
    asm volatile("s_waitcnt lgkmcnt(0)" ::: "memory");
    {
        const int tc = lane & 31;
        float x[32];
        x[31] = (tc == 31) ? 1.f : 0.f;
#pragma unroll
        for (int s = 30; s >= 0; --s) {
            float acc = 0.f;
#pragma unroll
            for (int j4 = (s + 1) / 4; j4 < 8; ++j4) { const f32x4 mrow = *(const LAS f32x4*)(W + RA_ZLO + (s * 32 + 4 * j4) * 4);
#pragma unroll
                for (int e = 0; e < 4; ++e) if (4 * j4 + e > s) acc += mrow[e] * x[4 * j4 + e]; }
            x[s] = (s == tc) ? 1.f : ((s < tc) ? -acc : 0.f);
            asm volatile("" : "+v"(x[s]) :: "memory");
        }
        asm volatile("s_waitcnt lgkmcnt(0)" ::: "memory");
#pragma unroll
        for (int q = 0; q < 4; ++q) *(LAS u32x4*)(W + RA_ZLO + tc * 80 + 16 * q) = (u32x4){pk2(x[8 * q], x[8 * q + 1]), pk2(x[8 * q + 2], x[8 * q + 3]), pk2(x[8 * q + 4], x[8 * q + 5]), pk2(x[8 * q + 6], x[8 * q + 7])};
    }
    asm volatile("s_waitcnt lgkmcnt(0)" ::: "memory");
    {
        const bf16x8 tb0 = lds16(W + RA_ZLO + i * 80 + 16 * g), tb1 = lds16(W + RA_ZLO + (16 + i) * 80 + 16 * g);
#pragma unroll 1
        for (int mt = 0; mt < 6; ++mt) {
            const bf16x8 xa = lds16(W + (mt < 4 ? RA_DT + (16 * mt + i) * 80 : RA_M2 + (16 * (mt - 4) + i) * 80) + 16 * g);
            const f32x4 x0 = MFMA16(xa, tb0, ((f32x4){0.f, 0.f, 0.f, 0.f})), x1 = MFMA16(xa, tb1, ((f32x4){0.f, 0.f, 0.f, 0.f}));
#pragma unroll
            for (int r = 0; r < 4; ++r) { *(LAS bf16_t*)(W + RA_ZLO + (16 * mt + 4 * g + r) * 80 + i * 2) = f2bf(x0[r]); *(LAS bf16_t*)(W + RA_ZLO + (16 * mt + 4 * g + r) * 80 + (16 + i) * 2) = f2bf(x1[r]); }
        }
    }
    asm volatile("s_waitcnt lgkmcnt(0)" ::: "memory");
    {
        bf16x8 xa[6];
#pragma unroll
        for (int mt = 0; mt < 6; ++mt) xa[mt] = lds16(W + RA_ZLO + (16 * mt + i) * 80 + 16 * g);
#pragma unroll 1
        for (int nt = 0; nt < 6; ++nt) {
            const unsigned li = launder_((unsigned)i), lg8 = launder_((unsigned)(8 * g));
            const bf16x8 bb = lds16(W + (nt < 2 ? RA_N1T + (16 * nt + i) * 80 : RA_AT + (16 * (nt - 2) + i) * 80) + 16 * g);
            if (nt < 2) {
                const int t = 16 * nt + i;
#pragma unroll
                for (int mt = 0; mt < 6; ++mt) {
                    const f32x4 o = MFMA16(xa[mt], bb, ((f32x4){0.f, 0.f, 0.f, 0.f}));
                    if (mt < 4) { const u32x2 rk = *(const LAS u32x2*)(W + RA_EHI + t * 144 + (16 * mt + 4 * g) * 2);
                        const float q0 = __uint_as_float(rk.x << 16) - o[0], q1 = __uint_as_float(rk.x & 0xffff0000u) - o[1], q2 = __uint_as_float(rk.y << 16) - o[2], q3 = __uint_as_float(rk.y & 0xffff0000u) - o[3];
                        *(u32x2*)(X + RX_QT + 32 * mt + nt * 2048 + (li * 128u + lg8)) = (u32x2){pk2(q0, q1), pk2(q2, q3)}; }
                    else { float n2[4];
#pragma unroll
                        for (int r = 0; r < 4; ++r) n2[r] = *(const LAS float*)(W + RA_ELO + ((16 * (mt - 4) + 4 * g + r) * 32 + t) * 4);
                        *(u32x2*)(X + RX_WYT + 32 * (mt - 4) + nt * 1024 + (li * 64u + lg8)) = (u32x2){pk2(n2[0] - o[0], n2[1] - o[1]), pk2(n2[2] - o[2], n2[3] - o[3])}; }
                }
            } else {
                const int kp = 16 * (nt - 2) + i; const float ccn = *(const LAS float*)(W + RA_CC + 4 * kp);
#pragma unroll
                for (int mt = 0; mt < 6; ++mt) {
                    const f32x4 o = MFMA16(xa[mt], bb, ((f32x4){0.f, 0.f, 0.f, 0.f}));
                    if (mt < 4) *(u32x2*)(X + RX_NGT + 32 * mt + (nt - 2) * 2048 + (li * 128u + lg8)) = (u32x2){pk2(-o[0] * ccn, -o[1] * ccn), pk2(-o[2] * ccn, -o[3] * ccn)};
                    else { float kc[4];
#pragma unroll
                        for (int r = 0; r < 4; ++r) kc[r] = bf2f(*(const LAS bf16_t*)(W + RA_ZHI + (16 * (mt - 4) + 4 * g + r) * 144 + 2 * kp));
                        *(u32x2*)(X + RX_HT + 32 * (mt - 4) + (nt - 2) * 1024 + (li * 64u + lg8)) = (u32x2){pk2((kc[0] - o[0]) * ccn, (kc[1] - o[1]) * ccn), pk2((kc[2] - o[2]) * ccn, (kc[3] - o[3]) * ccn)}; }
                }
            }
        }
    }
}

__device__ __forceinline__ void rwkv_chunked_bh(const Ctx& F, int b, int h) {
    const bf16_t* proj = (const bf16_t*)(F.ws + WS_BIG); const bf16_t* LO = (const bf16_t*)(F.ws + WS_LORA);
    bf16_t* Y = (bf16_t*)(F.ws + WS_HB);
    unsigned char* XS = F.ws + WS_AP + (size_t)F.bid * (RG * RX_BYTES);
    LAS unsigned char* L = F.lds;
    const int lane = lane_id_(), w = F.wid, i = lane & 15, g = lane >> 4, col = h * 64 + lane;
    const int vt = w >> 1, kh = w & 1;
    const float mu_v = F_mu[1024 + col], ln_w = F_ln_w[col], ln_b = F_ln_b[col];
    f32x4 sT[2] = {(f32x4){0.f, 0.f, 0.f, 0.f}, (f32x4){0.f, 0.f, 0.f, 0.f}};
#pragma unroll 1
    for (int grp = 0; grp < S / 32 / RG; ++grp) {
        __syncthreads();
        if (w < RG) rwkv_phaseA(F, L + w * RA_BYTES, XS + w * RX_BYTES, b, h, grp * RG + w);
        asm volatile("s_waitcnt vmcnt(0) lgkmcnt(0)" ::: "memory");
        __syncthreads();
#pragma unroll 1
        for (int cc = 0; cc < RG; ++cc) {
            const int c = grp * RG + cc; const unsigned char* X = XS + cc * RX_BYTES;
            bf16x8 ng[2][2], hf[2], qf[2], wyf, vf; f32x4 c4[2];
            const unsigned o128 = launder_((unsigned)(i * 128 + 16 * g)), o64 = launder_((unsigned)(i * 64 + 16 * g)), ulane = launder_((unsigned)lane);
#pragma unroll
            for (int q = 0; q < 2; ++q) { const int kt = 2 * kh + q;
                ng[q][0] = glb16(X + RX_NGT + 16 * kt * 128 + o128); ng[q][1] = glb16(X + RX_NGT + 16 * kt * 128 + 64 + o128);
                hf[q] = glb16(X + RX_HT + 16 * kt * 64 + o64); c4[q] = *(const f32x4*)(X + RX_CC + 16 * kt * 4 + (unsigned)(16 * g)); }
            qf[0] = glb16(X + RX_QT + 16 * kh * 128 + o128); qf[1] = glb16(X + RX_QT + 16 * kh * 128 + 64 + o128);
            wyf = glb16(X + RX_WYT + 16 * kh * 64 + o64); vf = glb16(X + RX_VT + 16 * vt * 64 + o64);
            bf16_t pv0[4], pv1[4], gq[4]; float bon[4];
#pragma unroll
            for (int j = 0; j < 4; ++j) { const int t = c * 32 + w + 8 * j; const size_t row = (size_t)b * S + t; const bf16_t* p = proj + row * IN_EVEN_P + RW_OFF + 1024 + h * 64; const unsigned ul = ulane;
                pv0[j] = p[ul]; pv1[j] = t > 0 ? (p - IN_EVEN_P)[ul] : (bf16_t)0; gq[j] = (LO + row * 1536 + 1024 + h * 64)[ul]; bon[j] = *(const float*)(X + RX_BON + 4 * (w + 8 * j)); }
#pragma unroll
            for (int q = 0; q < 2; ++q) *(LAS u32x2*)(L + RB_SB + (16 * vt + i) * 144 + (16 * (2 * kh + q) + 4 * g) * 2) = (u32x2){pk2(sT[q][0], sT[q][1]), pk2(sT[q][2], sT[q][3])};
            __syncthreads();
            const bf16x8 bs0 = lds16(L + RB_SB + (16 * vt + i) * 144 + (8 * g) * 2), bs1 = lds16(L + RB_SB + (16 * vt + i) * 144 + (32 + 8 * g) * 2);
            f32x4 y = MFMA16(qf[0], bs0, ((f32x4){0.f, 0.f, 0.f, 0.f})); y = MFMA16(qf[1], bs1, y); y = MFMA16(wyf, vf, y);
#pragma unroll
            for (int q = 0; q < 2; ++q) { f32x4 a = sT[q] * c4[q]; a = MFMA16(ng[q][0], bs0, a); a = MFMA16(ng[q][1], bs1, a); sT[q] = MFMA16(hf[q], vf, a); }
#pragma unroll
            for (int r = 0; r < 4; ++r) *(LAS float*)(L + RB_YL + ((16 * kh + 4 * g + r) * 64 + 16 * vt + i) * 4) = y[r];
            __syncthreads();
#pragma unroll
            for (int j = 0; j < 4; ++j) {
                const int tl = w + 8 * j; const size_t row = (size_t)b * S + c * 32 + tl;
                const float yv = *(const LAS float*)(L + RB_YL + (tl * 64 + lane) * 4);
                const float s1 = wave_sum_fast(yv), s2 = wave_sum_fast(yv * yv);
                const float mean = s1 * (1.0f / 64.f), var = fmaxf(s2 * (1.0f / 64.f) - mean * mean, 0.f);
                const float yn = (yv - mean) * (1.0f / sqrtf(var + 64e-5f)) * ln_w + ln_b;
                float v = bf2f(pv0[j]); v += (bf2f(pv1[j]) - v) * mu_v;
                (Y + row * D + 512 + h * 64)[ulane] = f2bf((yn + bon[j] * v) * bf2f(gq[j]));
            }
        }
    }
    __syncthreads();
}

constexpr int HC = 32;
__device__ __forceinline__ void hgrn_bh(const Ctx& F, int b, int h) {
    const bf16_t* proj = (const bf16_t*)(F.ws + WS_BIG); const float* lb = (const float*)(F.ws + WS_LB);
    bf16_t* Y = (bf16_t*)(F.ws + WS_HB);
    LAS float* Ql = (LAS float*)F.lds; LAS float* Fl = Ql + HC * 128; LAS float* Il = Fl + HC * 128; LAS float* Ol = Il + HC * 128;
    const int tid = (F.wid * 64 + lane_id_()), lane = lane_id_(), w = F.wid, kg = lane & 15, vq = lane >> 4;
    const int pk_ = tid & 127; const float lbk = lb[h * 128 + pk_];
    const float gn0 = F_hg_norm[lane], gn1 = F_hg_norm[64 + lane];
    float st[8][4];
#pragma unroll
    for (int i = 0; i < 8; ++i)
#pragma unroll
        for (int j = 0; j < 4; ++j) st[i][j] = 0.f;
    for (int ch = 0; ch < S / HC; ++ch) {
        const int t0 = ch * HC;
#pragma unroll
        for (int i = 0; i < HC / 4; ++i) {
            const int tl = (tid >> 7) + 4 * i; const size_t row = (size_t)b * S + t0 + tl;
            const bf16_t* p = proj + row * IN_ODD + h * 128 + pk_;
            Ql[tl * 128 + pk_] = siluf_(bf2f(p[0])); Fl[tl * 128 + pk_] = lbk + (1.0f - lbk) * sigmoidf_(bf2f(p[1024])); Il[tl * 128 + pk_] = bf2f(p[2048]);
        }
        __syncthreads();
#pragma unroll 2
        for (int tl = 0; tl < HC; ++tl) {
            const f32x4 f0 = *(const LAS f32x4*)(Fl + tl * 128 + 8 * kg), f1 = *(const LAS f32x4*)(Fl + tl * 128 + 8 * kg + 4);
            const f32x4 q0 = *(const LAS f32x4*)(Ql + tl * 128 + 8 * kg), q1 = *(const LAS f32x4*)(Ql + tl * 128 + 8 * kg + 4);
            const f32x4 i4 = *(const LAS f32x4*)(Il + tl * 128 + 16 * w + 4 * vq);
            f32x4 o = {0.f, 0.f, 0.f, 0.f};
#pragma unroll
            for (int kk = 0; kk < 8; ++kk) { const float f = kk < 4 ? f0[kk & 3] : f1[kk & 3], q = kk < 4 ? q0[kk & 3] : q1[kk & 3], kv = 1.0f - f;
#pragma unroll
                for (int vv = 0; vv < 4; ++vv) { st[kk][vv] = st[kk][vv] * f + kv * i4[vv]; o[vv] += q * st[kk][vv]; } }
#pragma unroll
            for (int vv = 0; vv < 4; ++vv) o[vv] = reduce16(o[vv]);
            if (kg == 0) *(LAS f32x4*)(Ol + tl * 128 + 16 * w + 4 * vq) = o;
        }
        __syncthreads();
#pragma unroll
        for (int i = 0; i < HC / 8; ++i) {
            const int tl = w + 8 * i; const size_t row = (size_t)b * S + t0 + tl;
            const float oa = Ol[tl * 128 + lane], ob = Ol[tl * 128 + 64 + lane];
            const float rstd = 1.0f / sqrtf(wave_sum(oa * oa + ob * ob) * (1.0f / 128.f) + 1e-6f);
            const bf16_t* gp = proj + row * IN_ODD + 3072 + h * 128;
            Y[row * D + h * 128 + lane] = f2bf(oa * rstd * gn0 * siluf_(bf2f(gp[lane])));
            Y[row * D + h * 128 + 64 + lane] = f2bf(ob * rstd * gn1 * siluf_(bf2f(gp[64 + lane])));
        }
        __syncthreads();
    }
}


constexpr int HQP = 272, HTP = 80, HOP = 528;
constexpr int H_QM = 0, H_KM = 8704, H_KD = 17408, H_VT = 27648, H_EM = 37888, H_EL = 38400, H_PART = 38912, H_O = 40960;
__device__ __forceinline__ bf16x8 ld_frag2(const LAS unsigned char* p) { const u32x2 a = *(const LAS u32x2*)p, b = *(const LAS u32x2*)(p + 32); const u32x4 v = {a.x, a.y, b.x, b.y}; return __builtin_bit_cast(bf16x8, v); }
__device__ __forceinline__ bf16x8 pack8(const f32x4 a, const f32x4 b) { const u32x4 v = {pk2(a[0], a[1]), pk2(a[2], a[3]), pk2(b[0], b[1]), pk2(b[2], b[3])}; return __builtin_bit_cast(bf16x8, v); }
constexpr int HSTG = 57856;
__device__ __forceinline__ void hgrn_post(const Ctx& F, const LAS unsigned char* Lp, bf16_t* Y, int b, int h, int c, int w, int lane, float gn0, float gn1, const bf16_t (&gq)[4][2]) {
#pragma unroll
    for (int i = 0; i < 4; ++i) {
        const int tl = w + 8 * i; const size_t row = (size_t)b * S + 32 * c + tl;
        const float oa = *(const LAS float*)(Lp + H_O + tl * HOP + 4 * lane), ob = *(const LAS float*)(Lp + H_O + tl * HOP + 4 * (64 + lane));
        const float rstd = 1.0f / sqrtf(wave_sum_fast(oa * oa + ob * ob) * (1.0f / 128.f) + 1e-6f);
        Y[row * D + h * 128 + lane] = f2bf(oa * rstd * gn0 * bf2f(gq[i][0]));
        Y[row * D + h * 128 + 64 + lane] = f2bf(ob * rstd * gn1 * bf2f(gq[i][1]));
    }
}
__device__ __forceinline__ void hgrn_chunked_bh(const Ctx& F, int b, int h) {
    const bf16_t* proj = (const bf16_t*)(F.ws + WS_BIG); const float* lb = (const float*)(F.ws + WS_LB);
    bf16_t* Y = (bf16_t*)(F.ws + WS_HB);
    LAS unsigned char* L = F.lds;
    const int lane = lane_id_(), w = F.wid, tid = w * 64 + lane, c16 = lane & 15, g = lane >> 4;
    const int pt = lane & 31, phalf = lane >> 5, k0 = 16 * w + 8 * phalf;
    float lb8[8];
    { const f32x4 l0 = *(const f32x4*)(lb + h * 128 + k0), l1 = *(const f32x4*)(lb + h * 128 + k0 + 4); lb8[0] = l0[0]; lb8[1] = l0[1]; lb8[2] = l0[2]; lb8[3] = l0[3]; lb8[4] = l1[0]; lb8[5] = l1[1]; lb8[6] = l1[2]; lb8[7] = l1[3]; }
    const float gn0 = F_hg_norm[lane], gn1 = F_hg_norm[64 + lane];
    f32x4 st[8];
#pragma unroll
    for (int i = 0; i < 8; ++i) st[i] = (f32x4){0.f, 0.f, 0.f, 0.f};
    u32x4 rq, rf, rv;
    { const bf16_t* p = proj + ((size_t)b * S + pt) * IN_ODD + h * 128 + k0; rq = *(const u32x4*)p; rf = *(const u32x4*)(p + 1024); rv = *(const u32x4*)(p + 2048); }
    bf16_t gqp[4][2] = {};
    for (int c = 0; c < S / 32; ++c) {
        LAS unsigned char* const Ls = L + (c & 1) * HSTG;
        {
            float q[8], fv[8], Bv[8], kk[8];
            unpack8(rq, q); unpack8(rf, fv);
#pragma unroll
            for (int e = 0; e < 8; ++e) {
                const float f = lb8[e] + (1.0f - lb8[e]) * sigmoidf_(fv[e]); kk[e] = 1.0f - f;
                float x = __logf(f);
                x += __int_as_float(__builtin_amdgcn_update_dpp(0, __float_as_int(x), 0x111, 0xf, 0xf, false));
                x += __int_as_float(__builtin_amdgcn_update_dpp(0, __float_as_int(x), 0x112, 0xf, 0xf, false));
                x += __int_as_float(__builtin_amdgcn_update_dpp(0, __float_as_int(x), 0x114, 0xf, 0xf, false));
                x += __int_as_float(__builtin_amdgcn_update_dpp(0, __float_as_int(x), 0x118, 0xf, 0xf, false));
                x += __int_as_float(__builtin_amdgcn_update_dpp(0, __float_as_int(x), 0x142, 0xa, 0xf, false));
                Bv[e] = x;
            }
            LAS float* PW = (LAS float*)(Ls + H_PART);
            if (pt == 15) { *(LAS f32x4*)(PW + k0) = (f32x4){Bv[0], Bv[1], Bv[2], Bv[3]}; *(LAS f32x4*)(PW + k0 + 4) = (f32x4){Bv[4], Bv[5], Bv[6], Bv[7]}; }
            if (pt == 31) { *(LAS f32x4*)(PW + 128 + k0) = (f32x4){Bv[0], Bv[1], Bv[2], Bv[3]}; *(LAS f32x4*)(PW + 128 + k0 + 4) = (f32x4){Bv[4], Bv[5], Bv[6], Bv[7]}; }
            asm volatile("s_waitcnt lgkmcnt(0)" ::: "memory");
            const f32x4 m0 = *(const LAS f32x4*)(PW + k0), m1 = *(const LAS f32x4*)(PW + k0 + 4), e0 = *(const LAS f32x4*)(PW + 128 + k0), e1 = *(const LAS f32x4*)(PW + 128 + k0 + 4);
            float qm[8], km[8], kd[8];
#pragma unroll
            for (int e = 0; e < 8; ++e) { const float bmid = e < 4 ? m0[e & 3] : m1[e & 3], blast = e < 4 ? e0[e & 3] : e1[e & 3];
                const float ex = __expf(fminf(fmaxf(Bv[e] - bmid, -60.f), 60.f));
                qm[e] = q[e] * ex; km[e] = kk[e] * __builtin_amdgcn_rcpf(ex); kd[e] = km[e] * __expf(blast - bmid);
                if (pt == 31) { ((LAS float*)(Ls + H_EM))[k0 + e] = __expf(bmid); ((LAS float*)(Ls + H_EL))[k0 + e] = __expf(blast); } }
            *(LAS u32x4*)(Ls + H_QM + pt * HQP + 2 * k0) = (u32x4){pk2(qm[0], qm[1]), pk2(qm[2], qm[3]), pk2(qm[4], qm[5]), pk2(qm[6], qm[7])};
            *(LAS u32x4*)(Ls + H_KM + pt * HQP + 2 * k0) = (u32x4){pk2(km[0], km[1]), pk2(km[2], km[3]), pk2(km[4], km[5]), pk2(km[6], km[7])};
#pragma unroll
            for (int e = 0; e < 8; ++e) { *(LAS bf16_t*)(Ls + H_KD + (k0 + e) * HTP + 2 * pt) = f2bf(kd[e]);
                const unsigned wv = rv[e >> 1]; *(LAS bf16_t*)(Ls + H_VT + (k0 + e) * HTP + 2 * pt) = (bf16_t)((e & 1) ? (wv >> 16) : (wv & 0xffffu)); }
        }
        if (c + 1 < S / 32) { const bf16_t* p = proj + ((size_t)b * S + 32 * (c + 1) + pt) * IN_ODD + h * 128 + k0; rq = *(const u32x4*)p; rf = *(const u32x4*)(p + 1024); rv = *(const u32x4*)(p + 2048); }
        bf16_t gq[4][2];
#pragma unroll
        for (int i = 0; i < 4; ++i) { const bf16_t* gp = proj + ((size_t)b * S + 32 * c + w + 8 * i) * IN_ODD + 3072 + h * 128; gq[i][0] = gp[lane]; gq[i][1] = gp[64 + lane]; }
        __syncthreads();
        {
            bf16x8 qf[4][2];
#pragma unroll
            for (int s = 0; s < 4; ++s)
#pragma unroll
                for (int nt = 0; nt < 2; ++nt) qf[s][nt] = ld_frag2(Ls + H_QM + (c16 + 16 * nt) * HQP + (32 * s + 4 * g) * 2);
            f32x4 at[2][2];
#pragma unroll
            for (int mt = 0; mt < 2; ++mt)
#pragma unroll
                for (int nt = 0; nt < 2; ++nt) at[mt][nt] = (f32x4){0.f, 0.f, 0.f, 0.f};
#pragma unroll
            for (int s = 0; s < 4; ++s)
#pragma unroll
                for (int mt = 0; mt < 2; ++mt) { const bf16x8 ka = ld_frag2(Ls + H_KM + (c16 + 16 * mt) * HQP + (32 * s + 4 * g) * 2);
#pragma unroll
                    for (int nt = 0; nt < 2; ++nt) at[mt][nt] = __builtin_amdgcn_mfma_f32_16x16x32_bf16(ka, qf[s][nt], at[mt][nt], 0, 0, 0); }
#pragma unroll
            for (int mt = 0; mt < 2; ++mt)
#pragma unroll
                for (int nt = 0; nt < 2; ++nt)
#pragma unroll
                    for (int r = 0; r < 4; ++r) if (16 * mt + 4 * g + r > c16 + 16 * nt) at[mt][nt][r] = 0.f;
            f32x4 oT[2] = {(f32x4){0.f, 0.f, 0.f, 0.f}, (f32x4){0.f, 0.f, 0.f, 0.f}};
#pragma unroll
            for (int s = 0; s < 4; ++s) {
                const f32x4 e0 = *(const LAS f32x4*)(Ls + H_EM + (32 * s + 4 * g) * 4), e1 = *(const LAS f32x4*)(Ls + H_EM + (32 * s + 16 + 4 * g) * 4);
                const bf16x8 sA = pack8(st[2 * s] * e0, st[2 * s + 1] * e1);
#pragma unroll
                for (int nt = 0; nt < 2; ++nt) oT[nt] = __builtin_amdgcn_mfma_f32_16x16x32_bf16(sA, qf[s][nt], oT[nt], 0, 0, 0);
            }
            const bf16x8 vA = ld_frag2(Ls + H_VT + (16 * w + c16) * HTP + 8 * g);
#pragma unroll
            for (int nt = 0; nt < 2; ++nt) oT[nt] = __builtin_amdgcn_mfma_f32_16x16x32_bf16(vA, pack8(at[0][nt], at[1][nt]), oT[nt], 0, 0, 0);
#pragma unroll
            for (int mt = 0; mt < 8; ++mt) { const f32x4 el = *(const LAS f32x4*)(Ls + H_EL + (16 * mt + 4 * g) * 4);
                const bf16x8 kdA = ld_frag2(Ls + H_KD + (16 * mt + c16) * HTP + 8 * g);
                st[mt] = __builtin_amdgcn_mfma_f32_16x16x32_bf16(kdA, vA, st[mt] * el, 0, 0, 0); }
#pragma unroll
            for (int nt = 0; nt < 2; ++nt) *(LAS f32x4*)(Ls + H_O + (c16 + 16 * nt) * HOP + (16 * w + 4 * g) * 4) = oT[nt];
        }
        if (c > 0) hgrn_post(F, L + ((c - 1) & 1) * HSTG, Y, b, h, c - 1, w, lane, gn0, gn1, gqp);
#pragma unroll
        for (int i = 0; i < 4; ++i) { gqp[i][0] = gq[i][0]; gqp[i][1] = gq[i][1]; }
    }
    __syncthreads();
    hgrn_post(F, L + ((S / 32 - 1) & 1) * HSTG, Y, b, h, S / 32 - 1, w, lane, gn0, gn1, gqp);
    __syncthreads();
}

__device__ __forceinline__ void final_norm_phase(const Ctx& F) {
    const int ln = lane_id_();
    const bf16_t* xf = (const bf16_t*)(F.ws + WS_XF);
    const int gw = F.bid * NWAVES + F.wid, NGW = F.G * NWAVES;
    float ga[2][8];
#pragma unroll
    for (int j = 0; j < 2; ++j)
#pragma unroll
        for (int h = 0; h < 2; ++h) { const f32x4 g = *(const f32x4*)(F_final_norm + 8 * ln + 512 * j + 4 * h);
#pragma unroll
            for (int e = 0; e < 4; ++e) ga[j][4 * h + e] = g[e]; }
    for (int ch = gw; ch < T / 4; ch += NGW) {
        u32x4 raw[4][2]; float s[4];
#pragma unroll
        for (int u = 0; u < 4; ++u)
#pragma unroll
            for (int j = 0; j < 2; ++j) raw[u][j] = *(const u32x4*)(xf + (size_t)(4 * ch + u) * D + 8 * ln + 512 * j);
#pragma unroll
        for (int u = 0; u < 4; ++u) { s[u] = 0.f;
#pragma unroll
            for (int j = 0; j < 2; ++j) { float f[8]; unpack8(raw[u][j], f);
#pragma unroll
                for (int e = 0; e < 8; ++e) s[u] += f[e] * f[e]; }
            s[u] = wave_sum_fast(s[u]); }
#pragma unroll
        for (int u = 0; u < 4; ++u) { const float rstd = 1.0f / sqrtf(s[u] * (1.0f / D) + 1e-6f); float* xr = F.out + (size_t)(4 * ch + u) * D;
#pragma unroll
            for (int j = 0; j < 2; ++j) { float f[8]; unpack8(raw[u][j], f);
                *(f32x4*)(xr + 8 * ln + 512 * j) = (f32x4){f[0] * rstd * ga[j][0], f[1] * rstd * ga[j][1], f[2] * rstd * ga[j][2], f[3] * rstd * ga[j][3]};
                *(f32x4*)(xr + 8 * ln + 512 * j + 4) = (f32x4){f[4] * rstd * ga[j][4], f[5] * rstd * ga[j][5], f[6] * rstd * ga[j][6], f[7] * rstd * ga[j][7]}; } }
    }
}

#define XB_TMO      128
#define XB_XCNT(j)  (256  + 64 * (j))
#define XB_XSUB(j)  (1280 + 64 * (j))
#define XB_XGEN(j)  (2304 + 64 * (j))
#define XB_TOP      3328
#define XB_TOPGEN   3392
#define XCD_BAR_WORDS 3456
#define XB_SPIN_CAP (1u << 22)
__device__ __forceinline__ unsigned xb_ld(unsigned* p)              { return __hip_atomic_load(p, __ATOMIC_RELAXED, __HIP_MEMORY_SCOPE_AGENT); }
__device__ __forceinline__ unsigned xb_add(unsigned* p, unsigned v) { return __hip_atomic_fetch_add(p, v, __ATOMIC_RELAXED, __HIP_MEMORY_SCOPE_AGENT); }
__device__ __forceinline__ unsigned xb_xcc_id() { return (unsigned)__builtin_amdgcn_s_getreg((3 << 11) | 20) & 0xFu; }
#define XB_SPIN(cond, bar) do { unsigned _sp = 0; while (cond) { __builtin_amdgcn_s_sleep(1); \
    if ((++_sp & 255u) == 0u) { if (xb_ld(&(bar)[XB_TMO])) break; if (_sp > XB_SPIN_CAP) { atomicAdd(&(bar)[XB_TMO], 1u); break; } } } } while (0)
__device__ __forceinline__ void xcd_barrier_complete(unsigned* bar, unsigned x, unsigned& nloc, unsigned& nx) {
    const unsigned G = gridDim.x;
    unsigned sum, cnt, mine, sp = 0u;
    for (;;) {
        sum = 0u; cnt = 0u; mine = 0u;
#pragma unroll
        for (unsigned j = 0; j < 16; ++j) { const unsigned c = xb_ld(&bar[XB_XCNT(j)]); sum += c; cnt += (c > 0u) ? 1u : 0u; mine = (j == x) ? c : mine; }
        if (sum == G) break;
        __builtin_amdgcn_s_sleep(1);
        if ((++sp & 255u) == 0u) { if (xb_ld(&bar[XB_TMO])) break; if (sp > XB_SPIN_CAP) { atomicAdd(&bar[XB_TMO], 1u); break; } }
    }
    nloc = mine > 0u ? mine : 1u; nx = cnt > 0u ? cnt : 1u;
}
__device__ __forceinline__ void grid_bar(const Ctx& F, unsigned) {
    asm volatile("s_waitcnt vmcnt(0) lgkmcnt(0)" ::: "memory");
    __syncthreads();
    if (F.wid == 0) {
        if (lane_id_() == 0) {
            unsigned* bar = (unsigned*)(F.ws + WS_BAR);
            volatile LAS unsigned* st = (volatile LAS unsigned*)(F.lds + LDS_BYTES - 64);
            const unsigned x = xb_xcc_id();
            __builtin_amdgcn_s_waitcnt(0);
            unsigned nloc = st[0], nx = st[1];
            if (nloc == 0u) { xcd_barrier_complete(bar, x, nloc, nx); st[0] = nloc; st[1] = nx; }
            const unsigned old = xb_add(&bar[XB_XSUB(x)], 1u);
            const unsigned gen = old / nloc;
            if (old + 1u == (gen + 1u) * nloc) {
                __builtin_amdgcn_fence(__ATOMIC_RELEASE, "agent");
                asm volatile("s_waitcnt vmcnt(0)" ::: "memory");
                const unsigned og = xb_add(&bar[XB_TOP], 1u);
                const unsigned tg = og / nx;
                if (og + 1u == (tg + 1u) * nx) xb_add(&bar[XB_TOPGEN], 1u);
                else XB_SPIN(xb_ld(&bar[XB_TOPGEN]) == tg, bar);
                __builtin_amdgcn_fence(__ATOMIC_ACQUIRE, "agent");
                xb_add(&bar[XB_XGEN(x)], 1u);
                asm volatile("s_waitcnt vmcnt(0)" ::: "memory");
            } else {
                XB_SPIN(xb_ld(&bar[XB_XGEN(x)]) == gen, bar);
                __builtin_amdgcn_fence(__ATOMIC_ACQUIRE, "agent");
                asm volatile("s_waitcnt vmcnt(0)" ::: "memory");
            }
        }
    }
    __syncthreads();
}

__global__ void __launch_bounds__(NTHREADS) fwd_mega(Args args) {
    extern __shared__ __attribute__((aligned(16))) unsigned char lds_raw[];
    cg::grid_group grid = cg::this_grid();
    Ctx F;
    F.lds = (LAS unsigned char*)lds_raw; F.G = gridDim.x; F.bid = blockIdx.x; F.wid = __builtin_amdgcn_readfirstlane(threadIdx.x >> 6);
    F.out = args.out; F.ws = args.ws;
    unsigned char* ws = args.ws;
    if (threadIdx.x < 2) ((LAS unsigned*)(F.lds + LDS_BYTES - 64))[threadIdx.x] = 0u;
    if (threadIdx.x == 0) (void)xb_add((unsigned*)(ws + WS_BAR) + XB_XCNT(xb_xcc_id()), 1u);
    __syncthreads();
    const float* mod = (const float*)(ws + WS_MOD);
    bf16_t* HB = (bf16_t*)(ws + WS_HB); bf16_t* BIG = (bf16_t*)(ws + WS_BIG);
    bf16_t* XA = (bf16_t*)args.out; bf16_t* XF = (bf16_t*)(ws + WS_XF);
    const int lo = args.ph_lo, hi = args.ph_hi;
    int ph = 0; unsigned nbar = 0;
#define PHASE_BEGIN if (lo <= ph && ph < hi) { { unsigned long long ta_ = (unsigned long long)__builtin_amdgcn_kernarg_segment_ptr(); asm volatile("" : "+s"(ta_)); F.in = (const __attribute__((address_space(4))) unsigned long long*)ta_; }
#define PHASE_END   if (ph + 1 < hi) { if (ph == 0) grid.sync(); else for (int rb = 0; rb < REP_BAR; ++rb) grid_bar(F, (++nbar) * (unsigned)F.G); } } ++ph;
    pg8::StaticOrder SO;

#ifndef REP_NORM
#define REP_NORM 1
#endif
#ifndef REP_GEMM
#define REP_GEMM 1
#endif
#ifndef REP_P0
#define REP_P0 1
#endif
#ifndef REP_BAR
#define REP_BAR 1
#endif
#ifndef REP_ATTN
#define REP_ATTN 1
#endif
#ifndef REP_RWKV
#define REP_RWKV 1
#endif
#ifndef REP_HGRN
#define REP_HGRN 1
#endif
    PHASE_BEGIN for (int rep = 0; rep < REP_P0; ++rep) p0_prologue(F); PHASE_END
    PHASE_BEGIN for (int rep = 0; rep < REP_NORM; ++rep) norm_mod_phase(F, F_x, F_norm_mix, mod + 0 * 1024, mod + 1 * 1024); PHASE_END
    PHASE_BEGIN { pg8::Gemm g{HB, (const bf16_t*)(ws + WS_WINE)}; SO.init(T, IN_EVEN_P, F.G, F.bid);
        pg8::EpiBf16 E{BIG, IN_EVEN_P}; for (int rep = 0; rep < REP_GEMM; ++rep) pg8::gemm_phase<pg8::EpiBf16, true, 1024, 1024, 1024>(F.lds, F.wid, g, SO, E); } PHASE_END
    PHASE_BEGIN for (int rep = 0; rep < REP_NORM; ++rep) prep_even_phase(F); PHASE_END
    PHASE_BEGIN {
        { pg8::Gemm g{BIG, (const bf16_t*)(ws + WS_WUQ)}; SO.init(T, 768, F.G, F.bid);
          pg8::EpiQ E{(bf16_t*)(ws + WS_Q), (const float*)(ws + WS_STATS), (const float*)(ws + WS_CS)}; pg8::gemm_phase<pg8::EpiQ, true, 384, IN_EVEN_P, 384>(F.lds, F.wid, g, SO, E); }
        { pg8::Gemm g{BIG + 384, (const bf16_t*)(ws + WS_WUKV)}; SO.init(T, 1024, F.G, F.bid);
          pg8::EpiKV E{(bf16_t*)(ws + WS_KH), (bf16_t*)(ws + WS_VH), (const float*)(ws + WS_STATS)}; pg8::gemm_phase<pg8::EpiKV, true, 256, IN_EVEN_P, 256>(F.lds, F.wid, g, SO, E); }
        { pg8::Gemm g{(const bf16_t*)(ws + WS_AP), (const bf16_t*)(ws + WS_WLORA)}; SO.init(T, 1536, F.G, F.bid);
          pg8::EpiBf16 E{(bf16_t*)(ws + WS_LORA), 1536}; pg8::gemm_phase<pg8::EpiBf16, true, 256, 256, 256>(F.lds, F.wid, g, SO, E); }
    } PHASE_END
    PHASE_BEGIN { for (int it = F.bid; it < 256; it += F.G) for (int rep = 0; rep < REP_ATTN; ++rep) attn_bh(F, it >> 3, it & 7);
                  asm volatile("" ::: "memory");
                  for (int it = F.bid; it < 256; it += F.G) for (int rep = 0; rep < REP_RWKV; ++rep) rwkv_chunked_bh(F, it >> 3, it & 7); } PHASE_END
    PHASE_BEGIN { pg8::Gemm g{HB, (const bf16_t*)(ws + WS_WOUTE)}; SO.init(T, 1024, F.G, F.bid);
        pg8::EpiRes<false> E{F_x, XA, mod + 2 * 1024}; pg8::gemm_phase<pg8::EpiRes<false>, true, 1024, 1024, 1024>(F.lds, F.wid, g, SO, E); } PHASE_END
    PHASE_BEGIN for (int rep = 0; rep < REP_NORM; ++rep) norm_mod_bf16_phase(F, XA, F_norm_ffn, mod + 3 * 1024, mod + 4 * 1024); PHASE_END
    PHASE_BEGIN { pg8::Gemm g{HB, (const bf16_t*)(ws + WS_WGU)}; SO.init(T, 2 * FF, F.G, F.bid);
        pg8::EpiSwiglu E{BIG}; for (int rep = 0; rep < REP_GEMM; ++rep) pg8::gemm_phase<pg8::EpiSwiglu, true, 1024, 1024, 1024>(F.lds, F.wid, g, SO, E); } PHASE_END
    PHASE_BEGIN { pg8::Gemm g{BIG, (const bf16_t*)(ws + WS_WD)}; SO.init(T, 1024, F.G, F.bid);
        pg8::EpiRes<true> E{XA, XA, mod + 5 * 1024}; pg8::gemm_phase<pg8::EpiRes<true>, true, FF, FF, FF>(F.lds, F.wid, g, SO, E); } PHASE_END
    const float* mod1 = mod + (size_t)32 * 6144;
    PHASE_BEGIN for (int rep = 0; rep < REP_NORM; ++rep) norm_mod_bf16_phase(F, XA, F_norm_mix + 1024, mod1 + 0 * 1024, mod1 + 1 * 1024); PHASE_END
    PHASE_BEGIN { pg8::Gemm g{HB, (const bf16_t*)(ws + WS_WINO)}; SO.init(T, IN_ODD, F.G, F.bid);
        pg8::EpiOdd E{BIG}; for (int rep = 0; rep < REP_GEMM; ++rep) pg8::gemm_phase<pg8::EpiOdd, true, 1024, 1024, 1024>(F.lds, F.wid, g, SO, E); } PHASE_END
    PHASE_BEGIN for (int it = F.bid; it < 256; it += F.G) for (int rep = 0; rep < REP_HGRN; ++rep) hgrn_chunked_bh(F, it >> 3, it & 7); PHASE_END
    PHASE_BEGIN { pg8::Gemm g{HB, (const bf16_t*)(ws + WS_WOUTO)}; SO.init(T, 1024, F.G, F.bid);
        pg8::EpiRes<true> E{XA, XA, mod1 + 2 * 1024}; pg8::gemm_phase<pg8::EpiRes<true>, true, 1024, 1024, 1024>(F.lds, F.wid, g, SO, E); } PHASE_END
    PHASE_BEGIN for (int rep = 0; rep < REP_NORM; ++rep) norm_mod_bf16_phase(F, XA, F_norm_ffn + 1024, mod1 + 3 * 1024, mod1 + 4 * 1024); PHASE_END
    PHASE_BEGIN { pg8::Gemm g{HB, (const bf16_t*)(ws + WS_WGU) + (size_t)5632 * 1024}; SO.init(T, 2 * FF, F.G, F.bid);
        pg8::EpiSwiglu E{BIG}; for (int rep = 0; rep < REP_GEMM; ++rep) pg8::gemm_phase<pg8::EpiSwiglu, true, 1024, 1024, 1024>(F.lds, F.wid, g, SO, E); } PHASE_END
    PHASE_BEGIN { pg8::Gemm g{BIG, (const bf16_t*)(ws + WS_WD) + (size_t)1024 * FF}; SO.init(T, 1024, F.G, F.bid);
        pg8::EpiRes<true> E{XA, XF, mod1 + 5 * 1024}; pg8::gemm_phase<pg8::EpiRes<true>, true, FF, FF, FF>(F.lds, F.wid, g, SO, E); } PHASE_END
    PHASE_BEGIN final_norm_phase(F); PHASE_END
}
constexpr int N_PHASES = 18;

extern "C" void kernel_launch(void* const* d_in, const int* in_sizes, int n_in, void* d_out, int out_size, void* d_ws, size_t ws_size, hipStream_t stream) {
    static int grid = 0;
    if (grid == 0) {
        if (n_in != 32 || out_size != T * D || ws_size < WS_END) { fprintf(stderr, "kernel_launch: unexpected shapes (n_in %d out %d ws %zu)\n", n_in, out_size, ws_size); grid = -1; return; }
        int dev = 0, cus = 0, per_cu = 0;
        (void)hipGetDevice(&dev); (void)hipDeviceGetAttribute(&cus, hipDeviceAttributeMultiprocessorCount, dev);
        if (hipFuncSetAttribute((const void*)fwd_mega, hipFuncAttributeMaxDynamicSharedMemorySize, LDS_BYTES) != hipSuccess) { fprintf(stderr, "kernel_launch: hipFuncSetAttribute failed\n"); grid = -1; return; }
        if (hipOccupancyMaxActiveBlocksPerMultiprocessor(&per_cu, (const void*)fwd_mega, NTHREADS, LDS_BYTES) != hipSuccess || per_cu < 1) { fprintf(stderr, "kernel_launch: occupancy query says %d\n", per_cu); per_cu = 1; }
        (void)hipGetLastError();
        grid = cus > 0 ? cus : 256;
    }
    if (grid < 0) return;
    (void)hipMemsetAsync((unsigned char*)d_ws + WS_BAR, 0, XCD_BAR_WORDS * 4, stream);
    Args a{};
    for (int i = 0; i < 32; ++i) a.in[i] = d_in[i];
    a.out = (float*)d_out; a.ws = (unsigned char*)d_ws; a.ph_lo = 0; a.ph_hi = N_PHASES;
    void* kargs[] = {&a};
    hipError_t e = hipLaunchCooperativeKernel((const void*)fwd_mega, dim3(grid), dim3(NTHREADS), kargs, LDS_BYTES, stream);
    if (e != hipSuccess) fprintf(stderr, "cooperative launch failed: %s (grid %d)\n", hipGetErrorString(e), grid);
}
```
